# Optimizing an MI355X kernel written in HIP

```python
import jax
import jax.numpy as jnp
from jax import lax
import numpy as np

D_MODEL = 1024
BATCH = 8
SEQ = 4096
DEPTH = 4

GRID_W = 64
CTX_LEN = 256

N_MIXERS = 3
MIX_POOL, MIX_MLA, MIX_NA = 0, 1, 2
N_POOL_LAYERS = (DEPTH + 2) // 3
N_MLA_LAYERS = (DEPTH + 1) // 3
N_NA_LAYERS = DEPTH // 3

RMS_EPS = 1e-6

POOL_WINDOWS = (2, 4, 8, 16)
POOL_GROUPS = len(POOL_WINDOWS)
POOL_GROUP_DIM = D_MODEL // POOL_GROUPS

MLA_HEADS = D_MODEL // 128
MLA_NOPE = 128
MLA_ROPE = 64
MLA_V = 128
MLA_Q_LORA = 384
MLA_KV_LORA = 256
MLA_IN = MLA_Q_LORA + MLA_KV_LORA + MLA_ROPE
MLA_SCALE = (MLA_NOPE + MLA_ROPE) ** -0.5
ROPE_BASE = 10000.0
Q_BLOCK = 128

NA_HEADS = D_MODEL // 64
NA_HEAD_DIM = 64
NA_WIDTH = NA_HEADS * NA_HEAD_DIM
NA_ROWS = 8
NA_COLS = 16
NA_SCALE = NA_HEAD_DIM ** -0.5

FFN_HIDDEN = -(-8 * D_MODEL // (3 * 256)) * 256

kernel_name = "hybrid_pool_mla_natten_prefix_dit"


def rmsnorm(x, g):
    xf = x.astype(jnp.float32)
    y = xf * lax.rsqrt(jnp.mean(xf * xf, axis=-1, keepdims=True) + RMS_EPS)
    return (y * g.astype(jnp.float32)).astype(x.dtype)


def modulate(h, shift, scale):
    return h * (1 + scale) + shift


def adaln(cond, w, b):
    m = jax.nn.silu(cond) @ w + b
    return jnp.split(m, 6, axis=-1)


def swiglu(h, w_gu, w_down):
    g, u = jnp.split(h @ w_gu, 2, axis=-1)
    return (jax.nn.silu(g) * u) @ w_down


def attend(q, k, v, scale):
    s = jnp.einsum('bqhd,bkhd->bhqk', q, k).astype(jnp.float32) * scale
    p = jax.nn.softmax(s, axis=-1).astype(v.dtype)
    return jnp.einsum('bhqk,bkhd->bqhd', p, v)


def blocked_attend(q, k, v, scale):
    B, L, H, dk = q.shape
    nb = L // Q_BLOCK
    qb = q.reshape(B, nb, Q_BLOCK, H, dk).transpose(1, 0, 2, 3, 4)
    out = lax.map(lambda qi: attend(qi, k, v, scale), qb)
    return out.transpose(1, 0, 2, 3, 4).reshape(B, L, H, v.shape[-1])


def axial_rope_tables(L):
    t = jnp.arange(L)
    row = (t // GRID_W).astype(jnp.float32)
    col = (t % GRID_W).astype(jnp.float32)
    half = MLA_ROPE // 2
    inv = ROPE_BASE ** (-jnp.arange(0, half, 2, dtype=jnp.float32) / half)
    ang = jnp.concatenate([row[:, None] * inv, col[:, None] * inv], axis=-1)
    return jnp.cos(ang), jnp.sin(ang)


def apply_rope(x, cos, sin):
    half = x.shape[-1] // 2
    x1 = x[..., :half].astype(jnp.float32)
    x2 = x[..., half:].astype(jnp.float32)
    return jnp.concatenate([x1 * cos - x2 * sin, x1 * sin + x2 * cos], axis=-1).astype(x.dtype)


def pool_mixer(h, w, scale):
    B, L, D = h.shape
    hf = h.astype(jnp.float32)
    cs = jnp.concatenate([jnp.zeros((B, 1, D), jnp.float32), jnp.cumsum(hf, axis=1)], axis=1)
    pos = jnp.arange(L)
    groups = []
    for g, win in enumerate(POOL_WINDOWS):
        lo = jnp.clip(pos - win // 2, 0, L)
        hi = jnp.clip(pos + win - win // 2, 0, L)
        sl = slice(g * POOL_GROUP_DIM, (g + 1) * POOL_GROUP_DIM)
        cnt = (hi - lo).astype(jnp.float32)[None, :, None]
        groups.append((cs[:, hi, sl] - cs[:, lo, sl]) / cnt - hf[:, :, sl])
    pooled = jnp.stack(groups, axis=2).astype(h.dtype)
    y = jnp.einsum('blgc,gcd->blgd', pooled, w).reshape(B, L, D)
    return y * scale


def mla_queries(q_a, q_norm_g, w_qb):
    B, L, _ = q_a.shape
    q = (rmsnorm(q_a, q_norm_g) @ w_qb).reshape(B, L, MLA_HEADS, MLA_NOPE + MLA_ROPE)
    return q[..., :MLA_NOPE], q[..., MLA_NOPE:]


def mla_keys_values(kv_a, k_rope, kv_norm_g, w_kvb):
    B, L, _ = kv_a.shape
    kv = (rmsnorm(kv_a, kv_norm_g) @ w_kvb).reshape(B, L, MLA_HEADS, MLA_NOPE + MLA_V)
    k_rope_h = jnp.broadcast_to(k_rope[:, :, None, :], (B, L, MLA_HEADS, MLA_ROPE))
    k = jnp.concatenate([kv[..., :MLA_NOPE], k_rope_h], axis=-1)
    return k, kv[..., MLA_NOPE:]


def mla_mixer(h_lat, h_ctx, w_in, q_norm_g, kv_norm_g, w_qb, w_kvb, w_o, need_ctx_out):
    B, L, _ = h_lat.shape
    Lc = h_ctx.shape[1]
    cos, sin = axial_rope_tables(L)
    a_lat = h_lat @ w_in
    qn, qr = mla_queries(a_lat[..., :MLA_Q_LORA], q_norm_g, w_qb)
    q_lat = jnp.concatenate([qn, apply_rope(qr, cos[:, None, :], sin[:, None, :])], axis=-1)
    k_lat, v_lat = mla_keys_values(a_lat[..., MLA_Q_LORA:MLA_Q_LORA + MLA_KV_LORA],
                                   apply_rope(a_lat[..., MLA_Q_LORA + MLA_KV_LORA:], cos, sin),
                                   kv_norm_g, w_kvb)
    a_ctx_kv = h_ctx @ w_in[:, MLA_Q_LORA:]
    k_ctx, v_ctx = mla_keys_values(a_ctx_kv[..., :MLA_KV_LORA], a_ctx_kv[..., MLA_KV_LORA:], kv_norm_g, w_kvb)
    k_all = jnp.concatenate([k_ctx, k_lat], axis=1)
    v_all = jnp.concatenate([v_ctx, v_lat], axis=1)
    y_lat = blocked_attend(q_lat, k_all, v_all, MLA_SCALE).reshape(B, L, MLA_HEADS * MLA_V) @ w_o
    y_ctx = None
    if need_ctx_out:
        qn_c, qr_c = mla_queries(h_ctx @ w_in[:, :MLA_Q_LORA], q_norm_g, w_qb)
        q_ctx = jnp.concatenate([qn_c, qr_c], axis=-1)
        y_ctx = attend(q_ctx, k_ctx, v_ctx, MLA_SCALE).reshape(B, Lc, MLA_HEADS * MLA_V) @ w_o
    return y_lat, y_ctx


def na_mixer(h_lat, h_ctx, w_in, rpb, w_o, need_ctx_out):
    B, L, _ = h_lat.shape
    Lc = h_ctx.shape[1]
    rows = L // GRID_W
    kr = min(NA_ROWS, rows)
    qkv = (h_lat @ w_in).reshape(B, rows, GRID_W, 3, NA_HEADS, NA_HEAD_DIM)
    q_grid, k_grid, v_grid = qkv[:, :, :, 0], qkv[:, :, :, 1], qkv[:, :, :, 2]
    kv_ctx = (h_ctx @ w_in[:, NA_WIDTH:]).reshape(B, Lc, 2, NA_HEADS, NA_HEAD_DIM)
    k_ctx, v_ctx = kv_ctx[:, :, 0], kv_ctx[:, :, 1]

    cols = jnp.arange(GRID_W)
    col_start = jnp.clip(cols - NA_COLS // 2, 0, GRID_W - NA_COLS)
    col_mask = (cols[None, :] >= col_start[:, None]) & (cols[None, :] < col_start[:, None] + NA_COLS)
    dc_idx = jnp.clip(cols[None, :] - cols[:, None] + NA_COLS - 1, 0, 2 * NA_COLS - 2)
    rpb_f = rpb.astype(jnp.float32)
    row_ids = jnp.arange(rows)
    row_start = jnp.clip(row_ids - kr // 2, 0, rows - kr)

    def row_block(args):
        r, rs, q_r = args
        k_r = lax.dynamic_slice_in_dim(k_grid, rs, kr, axis=1)
        v_r = lax.dynamic_slice_in_dim(v_grid, rs, kr, axis=1)
        dr_idx = rs + jnp.arange(kr) - r + NA_ROWS - 1
        bias = rpb_f[:, dr_idx][:, :, dc_idx].transpose(0, 2, 1, 3)
        s_loc = jnp.einsum('bqhd,bikhd->bhqik', q_r, k_r).astype(jnp.float32) * NA_SCALE + bias
        s_loc = jnp.where(col_mask[:, None, :], s_loc, -jnp.inf)
        s_ctx = jnp.einsum('bqhd,bkhd->bhqk', q_r, k_ctx).astype(jnp.float32) * NA_SCALE
        s = jnp.concatenate([s_loc.reshape(B, NA_HEADS, GRID_W, kr * GRID_W), s_ctx], axis=-1)
        p = jax.nn.softmax(s, axis=-1).astype(v_r.dtype)
        p_loc = p[..., :kr * GRID_W].reshape(B, NA_HEADS, GRID_W, kr, GRID_W)
        p_ctx = p[..., kr * GRID_W:]
        return (jnp.einsum('bhqik,bikhd->bqhd', p_loc, v_r)
                + jnp.einsum('bhqk,bkhd->bqhd', p_ctx, v_ctx))

    o = lax.map(row_block, (row_ids, row_start, q_grid.transpose(1, 0, 2, 3, 4)))
    y_lat = o.transpose(1, 0, 2, 3, 4).reshape(B, L, NA_WIDTH) @ w_o
    y_ctx = None
    if need_ctx_out:
        q_ctx = (h_ctx @ w_in[:, :NA_WIDTH]).reshape(B, Lc, NA_HEADS, NA_HEAD_DIM)
        y_ctx = attend(q_ctx, k_ctx, v_ctx, NA_SCALE).reshape(B, Lc, NA_WIDTH) @ w_o
    return y_lat, y_ctx


def setup_inputs(seed: int = 0) -> dict:
    key = jax.random.key(seed)
    ks = jax.random.split(key, 20)
    D = D_MODEL
    G = POOL_GROUP_DIM

    def nrm(k, shape, scale):
        return jax.random.normal(k, shape, jnp.float32) * scale

    return {
        "x": nrm(ks[0], (BATCH, SEQ, D), 1.0),
        "c": nrm(ks[1], (BATCH, D), 1.0),
        "ctx": nrm(ks[2], (BATCH, CTX_LEN, D), 1.0),
        "c_ctx": nrm(ks[3], (D,), 1.0),
        "ada_w": nrm(ks[4], (DEPTH, D, 6 * D), 0.5 * D ** -0.5),
        "ada_b": nrm(ks[5], (DEPTH, 6 * D), 0.02),
        "norm_g": 1.0 + nrm(ks[6], (DEPTH, 4, D), 0.05),
        "ffn_w_gu": nrm(ks[7], (DEPTH, D, 2 * FFN_HIDDEN), D ** -0.5),
        "ffn_w_down": nrm(ks[8], (DEPTH, FFN_HIDDEN, D), FFN_HIDDEN ** -0.5),
        "pool_w": nrm(ks[9], (N_POOL_LAYERS, POOL_GROUPS, G, G), G ** -0.5),
        "pool_scale": 1.0 + nrm(ks[10], (N_POOL_LAYERS, D), 0.1),
        "mla_w_in": nrm(ks[11], (N_MLA_LAYERS, D, MLA_IN), D ** -0.5),
        "mla_q_norm": 1.0 + nrm(ks[12], (N_MLA_LAYERS, MLA_Q_LORA), 0.05),
        "mla_kv_norm": 1.0 + nrm(ks[13], (N_MLA_LAYERS, MLA_KV_LORA), 0.05),
        "mla_w_qb": nrm(ks[14], (N_MLA_LAYERS, MLA_Q_LORA, MLA_HEADS * (MLA_NOPE + MLA_ROPE)), MLA_Q_LORA ** -0.5),
        "mla_w_kvb": nrm(ks[15], (N_MLA_LAYERS, MLA_KV_LORA, MLA_HEADS * (MLA_NOPE + MLA_V)), MLA_KV_LORA ** -0.5),
        "mla_w_o": nrm(ks[16], (N_MLA_LAYERS, MLA_HEADS * MLA_V, D), (MLA_HEADS * MLA_V) ** -0.5),
        "na_w_in": nrm(ks[17], (N_NA_LAYERS, D, 3 * NA_WIDTH), D ** -0.5),
        "na_rpb": nrm(ks[18], (N_NA_LAYERS, NA_HEADS, 2 * NA_ROWS - 1, 2 * NA_COLS - 1), 0.5),
        "na_w_o": nrm(ks[19], (N_NA_LAYERS, NA_WIDTH, D), NA_WIDTH ** -0.5),
    }


def reference(x, c, ctx, c_ctx, ada_w, ada_b, norm_g, ffn_w_gu, ffn_w_down,
              pool_w, pool_scale, mla_w_in, mla_q_norm, mla_kv_norm, mla_w_qb, mla_w_kvb, mla_w_o,
              na_w_in, na_rpb, na_w_o):
    for i in range(DEPTH):
        kind = i % N_MIXERS
        j = i // N_MIXERS
        ctx_after = any(l % N_MIXERS != MIX_POOL for l in range(i + 1, DEPTH))
        ctx_here = ctx_after or kind != MIX_POOL

        sh_m, sc_m, g_m, sh_f, sc_f, g_f = adaln(c[:, None, :], ada_w[i], ada_b[i])
        h_lat = modulate(rmsnorm(x, norm_g[i, 0]), sh_m, sc_m)
        h_ctx = None
        if ctx_here:
            csh_m, csc_m, cg_m, csh_f, csc_f, cg_f = adaln(c_ctx, ada_w[i], ada_b[i])
            h_ctx = modulate(rmsnorm(ctx, norm_g[i, 0]), csh_m, csc_m)

        if kind == MIX_POOL:
            y_lat = pool_mixer(h_lat, pool_w[j], pool_scale[j])
            y_ctx = pool_mixer(h_ctx, pool_w[j], pool_scale[j]) if ctx_after else None
        elif kind == MIX_MLA:
            y_lat, y_ctx = mla_mixer(h_lat, h_ctx, mla_w_in[j], mla_q_norm[j], mla_kv_norm[j],
                                     mla_w_qb[j], mla_w_kvb[j], mla_w_o[j], ctx_after)
        else:
            y_lat, y_ctx = na_mixer(h_lat, h_ctx, na_w_in[j], na_rpb[j], na_w_o[j], ctx_after)

        x = x + g_m * rmsnorm(y_lat, norm_g[i, 1])
        f_lat = swiglu(modulate(rmsnorm(x, norm_g[i, 2]), sh_f, sc_f), ffn_w_gu[i], ffn_w_down[i])
        x = x + g_f * rmsnorm(f_lat, norm_g[i, 3])

        if ctx_after:
            ctx = ctx + cg_m * rmsnorm(y_ctx, norm_g[i, 1])
            f_ctx = swiglu(modulate(rmsnorm(ctx, norm_g[i, 2]), csh_f, csc_f), ffn_w_gu[i], ffn_w_down[i])
            ctx = ctx + cg_f * rmsnorm(f_ctx, norm_g[i, 3])
    return x
```

```cpp
#include <hip/hip_runtime.h>
#include <hip/hip_cooperative_groups.h>
#include <cstdio>
#include <cstdint>
namespace cg = cooperative_groups;

#define LAS __attribute__((address_space(3)))
typedef unsigned short bf16_t;
typedef short bf16x8 __attribute__((ext_vector_type(8)));
typedef short s16x4 __attribute__((ext_vector_type(4)));
typedef float f32x4 __attribute__((ext_vector_type(4)));
typedef float f32x16 __attribute__((ext_vector_type(16)));
typedef unsigned u32x4 __attribute__((ext_vector_type(4)));
typedef unsigned u32x2 __attribute__((ext_vector_type(2)));

#ifndef USE_CG_SYNC
#define USE_CG_SYNC 0
#endif

constexpr int DM = 1024, NB = 8, SEQ = 4096, CTXL = 256, FFH = 2816;
constexpr int M_LAT = NB * SEQ;
constexpr int M_CTX = NB * CTXL;
constexpr int M_ALL = M_LAT + M_CTX;
constexpr float RMS_EPS = 1e-6f;
constexpr float LOG2E = 1.4426950408889634f;
constexpr int NWAVES = 8, NTHREADS = 512;

constexpr size_t MiB = 1u << 20;
constexpr size_t WS_CTL = 0;
constexpr size_t CTL_BYTES = 65536;
constexpr size_t WS_MOD = 65536;
constexpr size_t WS_W = 1 * MiB;
constexpr size_t SZ_GU = (size_t)2 * FFH * DM * 2, SZ_DN = (size_t)DM * FFH * 2, SZ_POOL = (size_t)DM * 256 * 2;
constexpr size_t W_GU = WS_W, W_DN = W_GU + 4 * SZ_GU, W_POOL = W_DN + 4 * SZ_DN, W_MIN = W_POOL + 2 * SZ_POOL;
constexpr size_t W_QB = W_MIN + (size_t)768 * 1024 * 2, W_KVB = W_QB + (size_t)1536 * 384 * 2, W_MO = W_KVB + (size_t)2048 * 256 * 2;
constexpr size_t W_NIN = W_MO + (size_t)1024 * 1024 * 2, W_NO = W_NIN + (size_t)3072 * 1024 * 2, W_END = W_NO + (size_t)1024 * 1024 * 2;
static_assert(W_END <= 83 * MiB, "weights");
constexpr size_t WS_X = 91 * MiB;
constexpr size_t WS_Y = 159 * MiB;
constexpr size_t WS_S = 227 * MiB;
constexpr size_t WS_END = 465 * MiB;
constexpr size_t S_ACT = WS_S;
constexpr size_t S_P = WS_S;
constexpr size_t S_Q = WS_S;
constexpr size_t S_KV = WS_S + 102 * MiB;
constexpr size_t Y_A = WS_Y;
constexpr size_t Y_KR = WS_Y + 51 * MiB;
constexpr size_t H_QA = 0;
constexpr size_t H_KVA = (size_t)M_ALL * 384 * 2;
constexpr size_t H_O = 0;
constexpr size_t HB_YP = 72 * MiB;
constexpr size_t S_QKV = WS_S;

__device__ __forceinline__ unsigned cvt_pk_bf16(float lo, float hi) { unsigned r; asm volatile("v_cvt_pk_bf16_f32 %0, %1, %2" : "=v"(r) : "v"(lo), "v"(hi)); return r; }
__device__ __forceinline__ float bf2f(unsigned short s) { return __uint_as_float(((unsigned)s) << 16); }
__device__ __forceinline__ float bflo(unsigned w) { return __uint_as_float(w << 16); }
__device__ __forceinline__ float bfhi(unsigned w) { return __uint_as_float(w & 0xffff0000u); }
__device__ __forceinline__ float wave_sum(float v) {
#pragma unroll
    for (int o = 1; o < 64; o <<= 1) v += __shfl_xor(v, o);
    return v;
}
__device__ __forceinline__ float fast_rcp(float x) { return __builtin_amdgcn_rcpf(x); }
__device__ __forceinline__ float silu_f(float x) { return x * fast_rcp(1.0f + __builtin_amdgcn_exp2f(-x * LOG2E)); }

namespace pg8 {
constexpr int BM = 256, BK = 64, HALF = 128, HTB = HALF * BK * 2, STAGE_BYTES = 8 * HTB, NXCD = 8, WGM = 8;
__host__ __device__ __forceinline__ int lds_byte(int r, int c) { const int st = (r >> 4) * 2 + (c >> 5), rr = r & 15, cc = c & 31, ob = rr * 64 + cc * 2; return st * 1024 + (ob ^ (((ob >> 9) & 1) << 5)); }
__host__ __device__ __forceinline__ void stage_rc(int b, int& R, int& C) { const int st = b / 1024, sb = b % 1024, swz = sb ^ (((sb >> 9) & 1) << 5); R = (st >> 1) * 16 + swz / 64; C = (st & 1) * 32 + (swz % 64) / 2; }
__host__ __device__ __forceinline__ int perm32(int rho) { const int n = rho >> 4, i = rho & 15; return 8 * (i >> 2) + 4 * n + (i & 3); }

struct Unit { int pm, pn; };
struct Gemm { const bf16_t* A; const bf16_t* Bt; int M, N, K, lda, ldb, apn; };

struct StaticOrder {
    int nM, nN, nwg, G, c;
    __device__ void init(int M, int N, int G_, int c_) { nM = M / BM; nN = N / BM; nwg = nM * nN; G = G_; c = c_; }
    __device__ bool next(int i, Unit& u) const {
        const long L = (long)i * G + c; if (L >= nwg) return false;
        int wgid = (int)L; { const int q = nwg / NXCD, r = nwg % NXCD, xcd = wgid % NXCD, off = wgid / NXCD; wgid = (xcd < r ? xcd * (q + 1) : r * (q + 1) + (xcd - r) * q) + off; }
        const int nig = WGM * nN, gid = wgid / nig, fm = gid * WGM, gsz = (nM - fm) < WGM ? (nM - fm) : WGM;
        u.pm = fm + ((wgid % nig) % gsz); u.pn = (wgid % nig) / gsz; return true;
    }
};

struct EpiStore {
    bf16_t* O; int ldc;
    __device__ __forceinline__ void operator()(const f32x4 (&acc)[2][2][4][2], const Unit& u, int wr, int wc, int fr, int fq) const {
        const int row0 = u.pm * BM + wr * 64 + fr; const int col0 = u.pn * BM + wc * 32 + 8 * fq;
#pragma unroll
        for (int ai = 0; ai < 2; ++ai)
#pragma unroll
            for (int m = 0; m < 4; ++m) { bf16_t* rowp = O + (size_t)(row0 + ai * HALF + m * 16) * ldc + col0;
#pragma unroll
                for (int bj = 0; bj < 2; ++bj) { const f32x4 v0 = acc[ai][bj][m][0], v1 = acc[ai][bj][m][1];
                    u32x4 w; w.x = cvt_pk_bf16(v0[0], v0[1]); w.y = cvt_pk_bf16(v0[2], v0[3]); w.z = cvt_pk_bf16(v1[0], v1[1]); w.w = cvt_pk_bf16(v1[2], v1[3]);
                    *(u32x4*)(rowp + bj * HALF) = w; } }
    }
};
struct EpiSwiGLU {
    bf16_t* O; int ldc;
    __device__ __forceinline__ void operator()(const f32x4 (&acc)[2][2][4][2], const Unit& u, int wr, int wc, int fr, int fq) const {
        const int row0 = u.pm * BM + wr * 64 + fr; const int col0 = u.pn * HALF + wc * 32 + 8 * fq;
#pragma unroll
        for (int ai = 0; ai < 2; ++ai)
#pragma unroll
            for (int m = 0; m < 4; ++m) { bf16_t* rowp = O + (size_t)(row0 + ai * HALF + m * 16) * ldc + col0;
                const f32x4 g0 = acc[ai][0][m][0], g1 = acc[ai][0][m][1], u0 = acc[ai][1][m][0], u1 = acc[ai][1][m][1];
                u32x4 w; w.x = cvt_pk_bf16(silu_f(g0[0]) * u0[0], silu_f(g0[1]) * u0[1]); w.y = cvt_pk_bf16(silu_f(g0[2]) * u0[2], silu_f(g0[3]) * u0[3]);
                w.z = cvt_pk_bf16(silu_f(g1[0]) * u1[0], silu_f(g1[1]) * u1[1]); w.w = cvt_pk_bf16(silu_f(g1[2]) * u1[2], silu_f(g1[3]) * u1[3]);
                *(u32x4*)rowp = w; }
    }
};

struct EpiNA {
    bf16_t* Q; bf16_t* Kp; bf16_t* Vp;
    __device__ __forceinline__ void operator()(const f32x4 (&acc)[2][2][4][2], const Unit& u, int wr, int wc, int fr, int fq) const {
        const int row0 = u.pm * BM + wr * 64 + fr; const int sect = u.pn >> 2; const int cin0 = (u.pn & 3) * BM + wc * 32 + 8 * fq;
        bf16_t* plane = sect == 1 ? Kp : Vp;
#pragma unroll
        for (int ai = 0; ai < 2; ++ai)
#pragma unroll
            for (int m = 0; m < 4; ++m) { const int row = row0 + ai * HALF + m * 16;
                const bool isl = row < 32768; const int b = isl ? (row >> 12) : ((row - 32768) >> 8); const int tall = isl ? (row & 4095) : 4096 + ((row - 32768) & 255);
#pragma unroll
                for (int bj = 0; bj < 2; ++bj) { const f32x4 v0 = acc[ai][bj][m][0], v1 = acc[ai][bj][m][1]; const int cin = cin0 + bj * HALF;
                    u32x4 w; w.x = cvt_pk_bf16(v0[0], v0[1]); w.y = cvt_pk_bf16(v0[2], v0[3]); w.z = cvt_pk_bf16(v1[0], v1[1]); w.w = cvt_pk_bf16(v1[2], v1[3]);
                    bf16_t* dst = sect == 0 ? Q + (size_t)row * 1024 + cin : plane + ((size_t)(b * 16 + (cin >> 6)) * 4352 + tall) * 64 + (cin & 63);
                    *(u32x4*)dst = w; } }
    }
};
__device__ __forceinline__ void gemm_phase(LAS unsigned char* lds, const Gemm g, int G, int cidx, bf16_t* O, int ldc, int emode) {
#ifdef NO_GEMM
    return;
#endif
    StaticOrder S; S.init(g.M, g.N, G, cidx);
    int tid = threadIdx.x; asm volatile("" : "+v"(tid));
    const int wid = __builtin_amdgcn_readfirstlane(tid >> 6), lane = tid & 63, wr = wid >> 2, wc = wid & 3, fr = lane & 15, fq = lane >> 4;
    const int K = g.K, nt = K / BK;
    unsigned voffA[2], voffB[2];
#pragma unroll
    for (int i = 0; i < 2; ++i) { int R, C; stage_rc(tid * 16 + i * 8192, R, C); const int Rb = (R & ~31) + perm32(R & 31);
        voffA[i] = (unsigned)(R * g.lda + C) * 2u; voffB[i] = (unsigned)(Rb * g.ldb + C) * 2u; }
    const size_t kstep = (size_t)(BK * 2);
    const size_t hstepA = (size_t)HALF * g.lda * 2, hstepB = (size_t)HALF * g.ldb * 2;
    const size_t tstepA = 2 * hstepA, tstepB = 2 * hstepB;
    const size_t apnB = (size_t)g.apn * 2;
    const unsigned ldsw = (unsigned)wid * 1024u;
    const int aoff = lds_byte(wr * 64 + fr, fq * 8), boff = lds_byte(wc * 32 + fr, fq * 8);
#define PG8_SA(b, h) (((b) * 2 + (h)) * HTB)
#define PG8_SB(b, h) ((4 + (b) * 2 + (h)) * HTB)
#define PG8_STAGE(bufoff, gbase, voff) do { _Pragma("unroll") for (int _i = 0; _i < 2; ++_i) \
        __builtin_amdgcn_global_load_lds((const unsigned*)((const char*)(gbase) + (voff)[_i]), (LAS unsigned*)(lds + (bufoff) + ldsw + _i * 8192), 16, 0, 0); } while (0)
#define PG8_LDA(dst, b, h) do { _Pragma("unroll") for (int m = 0; m < 4; ++m) _Pragma("unroll") for (int k = 0; k < 2; ++k) dst[m][k] = *(const LAS bf16x8*)(lds + PG8_SA(b, h) + aoff + m * 2048 + k * 1024); } while (0)
#define PG8_LDB(dst, b, h) do { _Pragma("unroll") for (int n = 0; n < 2; ++n) _Pragma("unroll") for (int k = 0; k < 2; ++k) dst[n][k] = *(const LAS bf16x8*)(lds + PG8_SB(b, h) + boff + n * 2048 + k * 1024); } while (0)
#define PG8_MMA(ai, bj, At, Bt) do { __builtin_amdgcn_s_setprio(1); _Pragma("unroll") for (int m = 0; m < 4; ++m) _Pragma("unroll") for (int n = 0; n < 2; ++n) _Pragma("unroll") for (int k = 0; k < 2; ++k) \
        acc[ai][bj][m][n] = __builtin_amdgcn_mfma_f32_16x16x32_bf16(Bt[n][k], At[m][k], acc[ai][bj][m][n], 0, 0, 0); __builtin_amdgcn_s_setprio(0); } while (0)
#define PG8_WAIT_V(n) asm volatile("s_waitcnt vmcnt(" #n ")" ::: "memory")
#define PG8_WAIT_L(n) asm volatile("s_waitcnt lgkmcnt(" #n ")" ::: "memory")
#define PG8_BAR __builtin_amdgcn_s_barrier()
#define PG8_SCHED __builtin_amdgcn_sched_barrier(0)
    Unit cur, nxt; int ui = 0;
    if (!S.next(0, cur)) return;
    f32x4 acc[2][2][4][2];
#pragma unroll
    for (int a = 0; a < 2; ++a)
#pragma unroll
        for (int b = 0; b < 2; ++b)
#pragma unroll
            for (int m = 0; m < 4; ++m)
#pragma unroll
                for (int n = 0; n < 2; ++n) acc[a][b][m][n] = (f32x4){0.f, 0.f, 0.f, 0.f};
    bf16x8 At[4][2], B0[2][2], B1[2][2];
    const char* cA = (const char*)g.A + (size_t)cur.pm * tstepA + (size_t)cur.pn * apnB; const char* cB = (const char*)g.Bt + (size_t)cur.pn * tstepB;
    PG8_STAGE(PG8_SB(0, 0), cB, voffB); PG8_STAGE(PG8_SB(0, 1), cB + hstepB, voffB); PG8_STAGE(PG8_SA(0, 0), cA, voffA); PG8_STAGE(PG8_SA(0, 1), cA + hstepA, voffA);
    if (wr == 1) PG8_BAR;
    PG8_WAIT_V(2); PG8_BAR;
    PG8_STAGE(PG8_SB(1, 0), cB + kstep, voffB); PG8_STAGE(PG8_SA(1, 0), cA + kstep, voffA); PG8_STAGE(PG8_SB(1, 1), cB + hstepB + kstep, voffB);
    PG8_WAIT_V(6); PG8_BAR;
    for (;;) {
        const bool has_next = S.next(ui + 1, nxt);
        const char* nA = has_next ? (const char*)g.A + (size_t)nxt.pm * tstepA + (size_t)nxt.pn * apnB : cA; const char* nB = has_next ? (const char*)g.Bt + (size_t)nxt.pn * tstepB : cB;
        for (int t = 0; t < nt; t += 2) {
            const bool last = (t == nt - 2);
            const char* a1 = cA + (size_t)(t + 1) * kstep;
            const char* a2 = last ? nA : cA + (size_t)(t + 2) * kstep; const char* b2 = last ? nB : cB + (size_t)(t + 2) * kstep;
            const char* a3 = a2 + kstep; const char* b3 = b2 + kstep;
            PG8_LDB(B0, 0, 0); PG8_LDB(B1, 0, 1); PG8_SCHED; PG8_LDA(At, 0, 0); PG8_STAGE(PG8_SA(1, 1), a1 + hstepA, voffA);
            PG8_WAIT_V(8); PG8_WAIT_L(0); PG8_BAR; PG8_MMA(0, 0, At, B0); PG8_MMA(0, 1, At, B1); PG8_BAR; PG8_SCHED;
            PG8_LDA(At, 0, 1); PG8_STAGE(PG8_SB(0, 0), b2, voffB); PG8_STAGE(PG8_SB(0, 1), b2 + hstepB, voffB); PG8_STAGE(PG8_SA(0, 0), a2, voffA);
            PG8_WAIT_V(8); PG8_WAIT_L(0); PG8_BAR; PG8_MMA(1, 0, At, B0); PG8_MMA(1, 1, At, B1); PG8_BAR; PG8_SCHED;
            PG8_LDB(B0, 1, 0); PG8_LDB(B1, 1, 1); PG8_SCHED; PG8_LDA(At, 1, 0); PG8_STAGE(PG8_SA(0, 1), a2 + hstepA, voffA);
            PG8_WAIT_V(8); PG8_WAIT_L(0); PG8_BAR; PG8_MMA(0, 0, At, B0); PG8_MMA(0, 1, At, B1); PG8_BAR; PG8_SCHED;
            PG8_LDA(At, 1, 1); PG8_STAGE(PG8_SB(1, 0), b3, voffB); PG8_STAGE(PG8_SB(1, 1), b3 + hstepB, voffB); PG8_STAGE(PG8_SA(1, 0), a3, voffA);
            PG8_WAIT_V(8); PG8_WAIT_L(0); PG8_BAR; PG8_MMA(1, 0, At, B0); PG8_MMA(1, 1, At, B1); PG8_BAR; PG8_SCHED;
        }
        if (wr == 0) PG8_BAR;
        if (emode == 1) { EpiSwiGLU E{O, ldc}; E(acc, cur, wr, wc, fr, fq); }
        else if (emode == 2) { EpiNA E{O, O + (size_t)34816 * 1024, O + (size_t)34816 * 1024 + (size_t)128 * 4352 * 64}; E(acc, cur, wr, wc, fr, fq); }
        else { EpiStore E{O, ldc}; E(acc, cur, wr, wc, fr, fq); }
        if (!has_next) break;
#pragma unroll
        for (int a = 0; a < 2; ++a)
#pragma unroll
            for (int b = 0; b < 2; ++b)
#pragma unroll
                for (int m = 0; m < 4; ++m)
#pragma unroll
                    for (int n = 0; n < 2; ++n) acc[a][b][m][n] = (f32x4){0.f, 0.f, 0.f, 0.f};
        cur = nxt; cA = nA; cB = nB; ++ui;
        if (wr == 1) PG8_BAR;
    }
    PG8_WAIT_V(0);
    PG8_BAR;
#undef PG8_SA
#undef PG8_SB
#undef PG8_STAGE
#undef PG8_LDA
#undef PG8_LDB
#undef PG8_MMA
#undef PG8_WAIT_V
#undef PG8_WAIT_L
#undef PG8_BAR
#undef PG8_SCHED
}
}

namespace att {
#define SBAR() __builtin_amdgcn_sched_barrier(0)
__device__ __forceinline__ int crow(int r, int hi) { return (r & 3) + 8 * (r >> 2) + 4 * hi; }
constexpr int V_BUF = 16384, KOFF = 32768, WSOFF = 81920, TABOFF = 83968;
constexpr float THR = 8.f;
__device__ __forceinline__ int k_off(int row, int cb) { return row * 128 + (cb ^ (((row >> 1) & 7) << 4)); }
__device__ __forceinline__ int v_st(int k, int c) { const int kk = (k & ~0xC) | ((k & 4) << 1) | ((k & 8) >> 1); return ((kk >> 3) * 4 + (c >> 5)) * 512 + ((kk & 7) * 32 + (c & 31)) * 2; }
__device__ __forceinline__ int v_rd_base(int lane) { return ((lane & 3) << 3) | (((lane >> 2) & 3) << 6) | (((lane >> 4) & 1) << 5) | (((lane >> 5) & 1) << 8); }
constexpr int v_rd_off(int d0, int ks, int half) { return d0 * 512 + ks * 4096 + half * 2048; }
template <int OFF> __device__ __forceinline__ s16x4 tr_read(int vb) {
    s16x4 r; asm volatile("ds_read_b64_tr_b16 %0, %1 offset:%2" : "=&v"(r) : "v"(vb), "i"(OFF) : "memory"); return r;
}
template <int D0> __device__ __forceinline__ void pv_one(f32x16& od, int vb, bf16x8 pa0, bf16x8 pa1, bf16x8 pa2, bf16x8 pa3) {
    const s16x4 l0 = tr_read<v_rd_off(D0, 0, 0)>(vb), h0 = tr_read<v_rd_off(D0, 0, 1)>(vb), l1 = tr_read<v_rd_off(D0, 1, 0)>(vb), h1 = tr_read<v_rd_off(D0, 1, 1)>(vb);
    const s16x4 l2 = tr_read<v_rd_off(D0, 2, 0)>(vb), h2 = tr_read<v_rd_off(D0, 2, 1)>(vb), l3 = tr_read<v_rd_off(D0, 3, 0)>(vb), h3 = tr_read<v_rd_off(D0, 3, 1)>(vb);
    asm volatile("s_waitcnt lgkmcnt(0)" ::: "memory"); SBAR();
#define PK(L, H) (bf16x8){L[0], L[1], L[2], L[3], H[0], H[1], H[2], H[3]}
    od = __builtin_amdgcn_mfma_f32_32x32x16_bf16(pa0, PK(l0, h0), od, 0, 0, 0);
    od = __builtin_amdgcn_mfma_f32_32x32x16_bf16(pa1, PK(l1, h1), od, 0, 0, 0);
    od = __builtin_amdgcn_mfma_f32_32x32x16_bf16(pa2, PK(l2, h2), od, 0, 0, 0);
    od = __builtin_amdgcn_mfma_f32_32x32x16_bf16(pa3, PK(l3, h3), od, 0, 0, 0);
#undef PK
}

template <int DKB, int DVB>
__device__ __forceinline__ void compute_tile(LAS const unsigned char* Kb, int vb, const bf16x8* qr, f32x16* o, float& m_reg, float& l_reg, LAS float* ws,
                                             const float C, int r32, int hi, bool local, LAS const float* tp, const float* madd0, const float* madd1) {
            f32x16 p0 = f32x16{}, p1 = f32x16{};
            {
#pragma unroll
              for (int d0 = 0; d0 < DKB; ++d0) { const int cb = ((d0 & 3) * 16 + hi * 8) * 2;
                const bf16x8 b0 = *(LAS const bf16x8*)(Kb + (d0 >> 2) * 8192 + k_off(r32, cb));
                const bf16x8 b1 = *(LAS const bf16x8*)(Kb + (d0 >> 2) * 8192 + k_off(32 + r32, cb));
                p0 = __builtin_amdgcn_mfma_f32_32x32x16_bf16(b0, qr[d0], p0, 0, 0, 0);
                p1 = __builtin_amdgcn_mfma_f32_32x32x16_bf16(b1, qr[d0], p1, 0, 0, 0); } }
                        if (local) {
#pragma unroll
                for (int r = 0; r < 16; ++r) { const int kk = (r & 3) + 8 * (r >> 2);
                    p0[r] = fmaf(p0[r], C, tp[kk]) + madd0[r]; p1[r] = fmaf(p1[r], C, tp[32 + kk]) + madd1[r]; }
            }
            float pmax = p0[0];
#pragma unroll
            for (int r = 1; r < 16; ++r) pmax = fmaxf(pmax, p0[r]);
#pragma unroll
            for (int r = 0; r < 16; ++r) pmax = fmaxf(pmax, p1[r]);
            if (!local) pmax *= C;
            { auto rr = __builtin_amdgcn_permlane32_swap(__float_as_uint(pmax), __float_as_uint(pmax), false, false);
              pmax = fmaxf(__uint_as_float(rr[0]), __uint_as_float(rr[1])); }
            float alpha = 1.f;
            if (!__all(pmax - m_reg <= THR)) { const float mn = fmaxf(m_reg, pmax); alpha = __builtin_amdgcn_exp2f(m_reg - mn); m_reg = mn; }
            if (local) {
#pragma unroll
                for (int r = 0; r < 16; ++r) { p0[r] = __builtin_amdgcn_exp2f(p0[r] - m_reg); p1[r] = __builtin_amdgcn_exp2f(p1[r] - m_reg); }
            } else {
                const float nm = -m_reg;
#pragma unroll
                for (int r = 0; r < 16; ++r) { p0[r] = __builtin_amdgcn_exp2f(fmaf(p0[r], C, nm)); p1[r] = __builtin_amdgcn_exp2f(fmaf(p1[r], C, nm)); }
            }
            float ps = 0.f;
#pragma unroll
            for (int r = 0; r < 16; ++r) ps += p0[r];
#pragma unroll
            for (int r = 0; r < 16; ++r) ps += p1[r];
            { auto rr = __builtin_amdgcn_permlane32_swap(__float_as_uint(ps), __float_as_uint(ps), false, false);
              ps = __uint_as_float(rr[0]) + __uint_as_float(rr[1]); }
            l_reg = l_reg * alpha + ps;
            bf16x8 pa0, pa1, pa2, pa3;
#define PK4(P, BASE, OUT) do { unsigned a0 = cvt_pk_bf16(P[BASE + 0], P[BASE + 1]), a1 = cvt_pk_bf16(P[BASE + 2], P[BASE + 3]);   \
    unsigned b0 = cvt_pk_bf16(P[BASE + 4], P[BASE + 5]), b1 = cvt_pk_bf16(P[BASE + 6], P[BASE + 7]);                              \
    auto r0_ = __builtin_amdgcn_permlane32_swap(a0, b0, false, false); auto r1_ = __builtin_amdgcn_permlane32_swap(a1, b1, false, false); \
    u32x4 w_ = {r0_[0], r1_[0], r0_[1], r1_[1]}; OUT = __builtin_bit_cast(bf16x8, w_); } while (0)
            PK4(p0, 0, pa0); PK4(p0, 8, pa1); PK4(p1, 0, pa2); PK4(p1, 8, pa3);
#undef PK4
            if (__any(alpha < 1.f)) { if (hi == 0) ws[r32] = alpha; asm volatile("s_waitcnt lgkmcnt(0)" ::: "memory");
#pragma unroll
                for (int d = 0; d < DVB; ++d)
#pragma unroll
                    for (int r = 0; r < 16; ++r) o[d][r] *= ws[crow(r, hi)]; }
            SBAR();
            pv_one<0>(o[0], vb, pa0, pa1, pa2, pa3); pv_one<1>(o[1], vb, pa0, pa1, pa2, pa3);
            if constexpr (DVB == 4) { pv_one<2>(o[2], vb, pa0, pa1, pa2, pa3); pv_one<3>(o[3], vb, pa0, pa1, pa2, pa3); }
}

struct AttnU {
    const bf16_t* Qw; int ldq;
    const bf16_t* K0; int ldk0;
    const bf16_t* K2; int ldk2;
    const bf16_t* V; int ldv;
    bf16_t* O; int ldo;
    int baseA, nA, baseB, NT;
    int rope_pos0;
    int lo, r0;
    const float* rpb_h;
};

template <int DKB, int DVB, int MODE>
__device__ __forceinline__ void attn_unit(LAS unsigned char* lds, const AttnU& u, const float C) {
    int tid = threadIdx.x; asm volatile("" : "+v"(tid));
    const int lane = tid & 63, r32 = lane & 31, hi = lane >> 5;
    const int wid = __builtin_amdgcn_readfirstlane(tid >> 6);
    constexpr int NKR = DKB / 4, KBUF = NKR * 8192;
    LAS float* ws = (LAS float*)(lds + WSOFF) + wid * 64;
    LAS float* tab = (LAS float*)(lds + TABOFF);
    if constexpr (MODE == 1) { for (int i_ = tid; i_ < 640; i_ += NTHREADS) { const int s_ = i_ - 64; tab[i_] = (s_ >= 0 && s_ < 465) ? u.rpb_h[s_] * LOG2E : 0.f; } }
    bf16x8 qr[DKB];
    { const bf16_t* q = u.Qw + (size_t)(wid * 32 + r32) * u.ldq + hi * 8;
#pragma unroll
      for (int d0 = 0; d0 < DKB; ++d0) qr[d0] = *(const bf16x8*)(q + d0 * 16); }
    if constexpr (MODE == 0) {
        if (u.rope_pos0 >= 0) {
            const int t = u.rope_pos0 + wid * 32 + r32; const float grow = (float)(t >> 6), gcol = (float)(t & 63);
#pragma unroll
            for (int dd = 0; dd < 2; ++dd) {
                const float pos = dd == 0 ? grow : gcol;
#pragma unroll
                for (int j = 0; j < 8; ++j) {
                    const float inv = __builtin_amdgcn_exp2f(-(float)(8 * hi + j) * 0.8304820237218406f);
                    const float ang = pos * inv; const float cs = __cosf(ang), sn = __sinf(ang);
                    const float x1 = bf2f((unsigned short)qr[8 + dd][j]), x2 = bf2f((unsigned short)qr[10 + dd][j]);
                    const float o1 = x1 * cs - x2 * sn, o2 = x1 * sn + x2 * cs;
                    const unsigned w = cvt_pk_bf16(o1, o2);
                    qr[8 + dd][j] = (short)(w & 0xffffu); qr[10 + dd][j] = (short)(w >> 16);
                }
            }
        }
    }
    const int krow = tid >> 3, kc = tid & 7;
    const int kdst = k_off(krow, kc * 16);
    const int sr = tid >> 4, sc = (tid & 15) * 8;
    const int vdst0 = (MODE == 0) ? v_st(sr, sc) : v_st(krow, kc * 8);
    const int vdst1 = v_st(32 + sr, sc);
    bf16x8 ks[NKR], vs[DVB / 2];
#define TILE_ROW(t) (((t) < u.nA) ? (u.baseA + 64 * (t)) : (u.baseB + 64 * ((t) - u.nA)))
#define SLOAD(rb, KS, VS) do { const size_t kr_ = (size_t)((rb) + krow); \
        if constexpr (MODE == 0) { KS[0] = *(const bf16x8*)(u.K0 + kr_ * u.ldk0 + kc * 8); KS[1] = *(const bf16x8*)(u.K0 + kr_ * u.ldk0 + 64 + kc * 8); KS[2] = *(const bf16x8*)(u.K2 + kr_ * u.ldk2 + kc * 8); \
            VS[0] = *(const bf16x8*)(u.V + (size_t)((rb) + sr) * u.ldv + sc); VS[1] = *(const bf16x8*)(u.V + (size_t)((rb) + 32 + sr) * u.ldv + sc); } \
        else { KS[0] = *(const bf16x8*)(u.K0 + kr_ * u.ldk0 + kc * 8); VS[0] = *(const bf16x8*)(u.V + kr_ * u.ldv + kc * 8); } } while (0)
#define SWRITE(KO, KB, b, KS, VS) do { _Pragma("unroll") for (int g_ = 0; g_ < NKR; ++g_) *(LAS bf16x8*)(lds + (KO) + (b) * (KB) + g_ * 8192 + kdst) = KS[g_]; \
        *(LAS bf16x8*)(lds + (b) * V_BUF + vdst0) = VS[0]; if constexpr (MODE == 0) *(LAS bf16x8*)(lds + (b) * V_BUF + vdst1) = VS[1]; } while (0)
    const int vb0 = (int)(unsigned)(uintptr_t)(lds) + v_rd_base(lane);
    float m_reg = -1e30f, l_reg = 0.f;
    f32x16 o[DVB];
#pragma unroll
    for (int d = 0; d < DVB; ++d) o[d] = f32x16{};
    const int qc = 32 * (wid & 1) + r32; const int cs0 = min(max(qc - 8, 0), 48);
    const int rq = u.r0 + (wid >> 1); const int rs = min(max(rq - 4, 0), 56);
    float madd0[16], madd1[16];
    if constexpr (MODE == 1) {
#pragma unroll
        for (int r = 0; r < 16; ++r) { const int kc0 = crow(r, hi), kc1 = kc0 + 32;
            madd0[r] = ((kc0 >= cs0) && (kc0 < cs0 + 16)) ? 0.f : -__builtin_inff(); madd1[r] = ((kc1 >= cs0) && (kc1 < cs0 + 16)) ? 0.f : -__builtin_inff(); }
    }
    const int NT = u.NT;
    if constexpr (MODE == 0) {
        { const int rb0 = TILE_ROW(0); SLOAD(rb0, ks, vs); SWRITE(KOFF, KBUF, 0, ks, vs); }
        __syncthreads();
        for (int j = 0; j < NT; ++j) {
            const int buf = j & 1;
            if (j + 1 < NT) { const int rbn = TILE_ROW(j + 1); SLOAD(rbn, ks, vs); }
            compute_tile<DKB, DVB>(lds + KOFF + buf * KBUF, vb0 + buf * V_BUF, qr, o, m_reg, l_reg, ws, C, r32, hi, false, tab, madd0, madd1);
            if (j + 1 < NT) { SWRITE(KOFF, KBUF, buf ^ 1, ks, vs); }
            __syncthreads();
        }
    } else {
        constexpr int KOFF1 = 3 * V_BUF;
        bf16x8 ks2[NKR], vs2[DVB / 2];
        { const int rb0 = TILE_ROW(0); SLOAD(rb0, ks, vs); SWRITE(KOFF1, KBUF, 0, ks, vs); }
        if (NT > 1) { const int rb1 = TILE_ROW(1); SLOAD(rb1, ks2, vs2); }
        __syncthreads();
        int st = 0;
#define NA_STEP(j_, LS_K, LS_V, WS_K, WS_V) do { const int jj = (j_); \
            if (jj + 2 < NT) { const int rbn = TILE_ROW(jj + 2); SLOAD(rbn, LS_K, LS_V); } \
            bool active = true; int rho = 0; const bool local = jj < u.nA; \
            if (local) { rho = u.lo + jj; active = (rho >= rs) && (rho < rs + 8); } \
            if (active) compute_tile<DKB, DVB>(lds + KOFF1 + st * KBUF, vb0 + st * V_BUF, qr, o, m_reg, l_reg, ws, C, r32, hi, local, tab + 64 + ((rho - rq + 7) * 31 - qc + 15 + 4 * hi), madd0, madd1); \
            const int stn = (st == 2) ? 0 : st + 1; \
            if (jj + 1 < NT) { SWRITE(KOFF1, KBUF, stn, WS_K, WS_V); } \
            st = stn; __syncthreads(); } while (0)
        for (int j = 0; j < NT; j += 2) {
            NA_STEP(j, ks, vs, ks2, vs2);
            if (j + 1 < NT) NA_STEP(j + 1, ks2, vs2, ks, vs);
        }
#undef NA_STEP
    }
    if (hi == 0) ws[r32] = l_reg; asm volatile("s_waitcnt lgkmcnt(0)" ::: "memory");
    float rli[16];
#pragma unroll
    for (int r = 0; r < 16; ++r) rli[r] = fast_rcp(ws[crow(r, hi)]);
    bf16_t* Ow = u.O + (size_t)(wid * 32) * u.ldo;
#pragma unroll
    for (int r = 0; r < 16; ++r) { const int orow = crow(r, hi);
#pragma unroll
        for (int d0 = 0; d0 < DVB; ++d0) { const unsigned w = cvt_pk_bf16(o[d0][r] * rli[r], 0.f); Ow[(size_t)orow * u.ldo + d0 * 32 + r32] = (bf16_t)(w & 0xffffu); } }
    asm volatile("s_waitcnt lgkmcnt(0)" ::: "memory");
    __syncthreads();
#undef TILE_ROW
#undef SLOAD
#undef SWRITE
}
__device__ __forceinline__ int v_st2(int k, int c) { const int kk = (k & ~0xC) | ((k & 4) << 1) | ((k & 8) >> 1); return ((kk >> 3) * 2 + (c >> 5)) * 512 + ((kk & 7) * 32 + (c & 31)) * 2; }
constexpr int v_rd_off2(int d0, int ks, int half) { return d0 * 512 + ks * 2048 + half * 1024; }
template <int D0, int NK> __device__ __forceinline__ void pv_blk2(f32x16& od, int vb, bf16x8 pa0, bf16x8 pa1, bf16x8 pa2, bf16x8 pa3) {
    const s16x4 l0 = tr_read<v_rd_off2(D0, 0, 0)>(vb), h0 = tr_read<v_rd_off2(D0, 0, 1)>(vb), l1 = tr_read<v_rd_off2(D0, 1, 0)>(vb), h1 = tr_read<v_rd_off2(D0, 1, 1)>(vb);
    s16x4 l2 = l0, h2 = h0, l3 = l1, h3 = h1;
    if constexpr (NK == 4) { l2 = tr_read<v_rd_off2(D0, 2, 0)>(vb); h2 = tr_read<v_rd_off2(D0, 2, 1)>(vb); l3 = tr_read<v_rd_off2(D0, 3, 0)>(vb); h3 = tr_read<v_rd_off2(D0, 3, 1)>(vb); }
    asm volatile("s_waitcnt lgkmcnt(0)" ::: "memory"); SBAR();
#define PK(L, H) (bf16x8){L[0], L[1], L[2], L[3], H[0], H[1], H[2], H[3]}
    od = __builtin_amdgcn_mfma_f32_32x32x16_bf16(pa0, PK(l0, h0), od, 0, 0, 0);
    od = __builtin_amdgcn_mfma_f32_32x32x16_bf16(pa1, PK(l1, h1), od, 0, 0, 0);
    if constexpr (NK == 4) { od = __builtin_amdgcn_mfma_f32_32x32x16_bf16(pa2, PK(l2, h2), od, 0, 0, 0); od = __builtin_amdgcn_mfma_f32_32x32x16_bf16(pa3, PK(l3, h3), od, 0, 0, 0); }
#undef PK
}
#define NA2_PK4(P, BASE, OUT) do { unsigned a0_ = cvt_pk_bf16(P[BASE + 0], P[BASE + 1]), a1_ = cvt_pk_bf16(P[BASE + 2], P[BASE + 3]);   \
    unsigned b0_ = cvt_pk_bf16(P[BASE + 4], P[BASE + 5]), b1_ = cvt_pk_bf16(P[BASE + 6], P[BASE + 7]);                              \
    auto r0_ = __builtin_amdgcn_permlane32_swap(a0_, b0_, false, false); auto r1_ = __builtin_amdgcn_permlane32_swap(a1_, b1_, false, false); \
    u32x4 w_ = {r0_[0], r1_[0], r0_[1], r1_[1]}; OUT = __builtin_bit_cast(bf16x8, w_); } while (0)
__device__ __forceinline__ void attn_unit_na2(LAS unsigned char* lds, const AttnU& u, const float C) {
    int tid = threadIdx.x; asm volatile("" : "+v"(tid));
    const int lane = tid & 63, r32 = lane & 31, hi = lane >> 5;
    const int wid = __builtin_amdgcn_readfirstlane(tid >> 6);
    constexpr int TSZ = 24576, STG = 2 * TSZ, VOFFA = 8192, VOFFB = 16384, WS2 = 98304, TAB2 = 100352;
    LAS float* ws = (LAS float*)(lds + WS2) + wid * 64;
    LAS float* tab = (LAS float*)(lds + TAB2);
    for (int i_ = tid; i_ < 640; i_ += NTHREADS) { const int s_ = i_ - 64; tab[i_] = (s_ >= 0 && s_ < 465) ? u.rpb_h[s_] * LOG2E : 0.f; }
    const int pr = wid >> 2, g = wid & 3;
    const int ra = u.r0 + 2 * pr;
    const int sg = g == 0 ? 0 : (g == 1 ? 8 : (g == 2 ? 24 : 32));
    const int rl = ra + (r32 >> 4), qc = 16 * g + (r32 & 15);
    const int cs0 = min(max(qc - 8, 0), 48), rsl = min(max(rl - 4, 0), 56);
    const int rsA = min(max(ra - 4, 0), 56), rsB = min(max(ra + 1 - 4, 0), 56);
    bf16x8 qr[4];
    { const bf16_t* q = u.Qw + (size_t)((2 * pr + (r32 >> 4)) * 64 + 16 * g + (r32 & 15)) * u.ldq + hi * 8;
#pragma unroll
      for (int d0 = 0; d0 < 4; ++d0) qr[d0] = *(const bf16x8*)(q + d0 * 16); }
    const int krow = tid >> 3, kc = tid & 7;
    const int kdst = k_off(krow, kc * 16), vdstA = v_st2(krow, kc * 8), vdstB = v_st2((krow + 56) & 63, kc * 8);
    const int ldsb = (int)(unsigned)(uintptr_t)(lds);
    const int vbl = ldsb + ((g == 1 || g == 2) ? VOFFB : VOFFA) + ((g == 2) ? 2048 : (g == 3 ? 4096 : 0)) + v_rd_base(lane);
    const int vbc = ldsb + VOFFA + v_rd_base(lane);
    const int tq = sg + 4 * hi - cs0;
    float m_reg = -1e30f, l_reg = 0.f;
    f32x16 o[2]; o[0] = f32x16{}; o[1] = f32x16{};
    const int NT = u.NT;
#define TILE_ROW(t) (((t) < u.nA) ? (u.baseA + 64 * (t)) : (u.baseB + 64 * ((t) - u.nA)))
#define SLOAD1(t_, KS, VS) do { const size_t kr_ = (size_t)(TILE_ROW(t_) + krow); KS = *(const bf16x8*)(u.K0 + kr_ * u.ldk0 + kc * 8); VS = *(const bf16x8*)(u.V + kr_ * u.ldv + kc * 8); } while (0)
#define SWRITE1(sb_, KS, VS) do { *(LAS bf16x8*)((sb_) + kdst) = KS; *(LAS bf16x8*)((sb_) + VOFFA + vdstA) = VS; *(LAS bf16x8*)((sb_) + VOFFB + vdstB) = VS; } while (0)
    bf16x8 k0 = bf16x8{}, v0 = bf16x8{}, k1 = bf16x8{}, v1 = bf16x8{};
    const int NP = (NT + 1) >> 1;
    SLOAD1(0, k0, v0); if (NT > 1) SLOAD1(1, k1, v1);
    SWRITE1(lds, k0, v0); SWRITE1(lds + TSZ, k1, v1);
    __syncthreads();
    int toff = 0;
    auto na2_tile = [&](int jj) __attribute__((always_inline)) {
        LAS const unsigned char* sb = lds + toff;
        const bool local = jj < u.nA;
        f32x16 p0, p1; float alpha = 1.f; bf16x8 pa0, pa1, pa2 = bf16x8{}, pa3 = bf16x8{};
        if (local) {
            const int rho = u.lo + jj;
            if (!((rho >= rsA) && (rho < rsB + 8))) return;
            p0 = f32x16{};
#pragma unroll
            for (int d0 = 0; d0 < 4; ++d0) { const int cb = (d0 * 16 + hi * 8) * 2;
                const bf16x8 b0 = *(LAS const bf16x8*)(sb + k_off(sg + r32, cb));
                p0 = __builtin_amdgcn_mfma_f32_32x32x16_bf16(b0, qr[d0], p0, 0, 0, 0); }
            const bool rowok = (rho >= rsl) && (rho < rsl + 8);
            const int drc = min(max(rho - rl + 7, 0), 14);
            LAS const float* tp = tab + 64 + (drc * 31 - qc + 15 + sg + 4 * hi);
#pragma unroll
            for (int r = 0; r < 16; ++r) { const int kk = (r & 3) + 8 * (r >> 2);
                p0[r] = (rowok && ((unsigned)(kk + tq) < 16u)) ? fmaf(p0[r], C, tp[kk]) : -__builtin_inff(); }
            float pmax = p0[0];
#pragma unroll
            for (int r = 1; r < 16; ++r) pmax = fmaxf(pmax, p0[r]);
            { auto rr = __builtin_amdgcn_permlane32_swap(__float_as_uint(pmax), __float_as_uint(pmax), false, false);
              pmax = fmaxf(__uint_as_float(rr[0]), __uint_as_float(rr[1])); }
            if (!__all(pmax - m_reg <= THR)) { const float mn = fmaxf(m_reg, pmax); alpha = __builtin_amdgcn_exp2f(m_reg - mn); m_reg = mn; }
            float ps = 0.f;
#pragma unroll
            for (int r = 0; r < 16; ++r) { p0[r] = __builtin_amdgcn_exp2f(p0[r] - m_reg); ps += p0[r]; }
            { auto rr = __builtin_amdgcn_permlane32_swap(__float_as_uint(ps), __float_as_uint(ps), false, false);
              ps = __uint_as_float(rr[0]) + __uint_as_float(rr[1]); }
            l_reg = l_reg * alpha + ps;
            NA2_PK4(p0, 0, pa0); NA2_PK4(p0, 8, pa1);
        } else {
            p0 = f32x16{}; p1 = f32x16{};
#pragma unroll
            for (int d0 = 0; d0 < 4; ++d0) { const int cb = (d0 * 16 + hi * 8) * 2;
                const bf16x8 b0 = *(LAS const bf16x8*)(sb + k_off(r32, cb));
                const bf16x8 b1 = *(LAS const bf16x8*)(sb + k_off(32 + r32, cb));
                p0 = __builtin_amdgcn_mfma_f32_32x32x16_bf16(b0, qr[d0], p0, 0, 0, 0);
                p1 = __builtin_amdgcn_mfma_f32_32x32x16_bf16(b1, qr[d0], p1, 0, 0, 0); }
            float pmax = p0[0];
#pragma unroll
            for (int r = 1; r < 16; ++r) pmax = fmaxf(pmax, p0[r]);
#pragma unroll
            for (int r = 0; r < 16; ++r) pmax = fmaxf(pmax, p1[r]);
            pmax *= C;
            { auto rr = __builtin_amdgcn_permlane32_swap(__float_as_uint(pmax), __float_as_uint(pmax), false, false);
              pmax = fmaxf(__uint_as_float(rr[0]), __uint_as_float(rr[1])); }
            if (!__all(pmax - m_reg <= THR)) { const float mn = fmaxf(m_reg, pmax); alpha = __builtin_amdgcn_exp2f(m_reg - mn); m_reg = mn; }
            const float nm = -m_reg; float ps = 0.f;
#pragma unroll
            for (int r = 0; r < 16; ++r) { p0[r] = __builtin_amdgcn_exp2f(fmaf(p0[r], C, nm)); p1[r] = __builtin_amdgcn_exp2f(fmaf(p1[r], C, nm)); ps += p0[r] + p1[r]; }
            { auto rr = __builtin_amdgcn_permlane32_swap(__float_as_uint(ps), __float_as_uint(ps), false, false);
              ps = __uint_as_float(rr[0]) + __uint_as_float(rr[1]); }
            l_reg = l_reg * alpha + ps;
            NA2_PK4(p0, 0, pa0); NA2_PK4(p0, 8, pa1); NA2_PK4(p1, 0, pa2); NA2_PK4(p1, 8, pa3);
        }
        if (__any(alpha < 1.f)) { if (hi == 0) ws[r32] = alpha; asm volatile("s_waitcnt lgkmcnt(0)" ::: "memory");
#pragma unroll
            for (int d = 0; d < 2; ++d)
#pragma unroll
                for (int r = 0; r < 16; ++r) o[d][r] *= ws[crow(r, hi)]; }
        SBAR();
        if (local) { const int vb = vbl + toff; pv_blk2<0, 2>(o[0], vb, pa0, pa1, pa2, pa3); pv_blk2<1, 2>(o[1], vb, pa0, pa1, pa2, pa3); }
        else { const int vb = vbc + toff; pv_blk2<0, 4>(o[0], vb, pa0, pa1, pa2, pa3); pv_blk2<1, 4>(o[1], vb, pa0, pa1, pa2, pa3); }
    };
    for (int p = 0; p < NP; ++p) {
        const int sbase = (p & 1) * STG;
        if (p + 1 < NP) { SLOAD1(2 * p + 2, k0, v0); if (2 * p + 3 < NT) SLOAD1(2 * p + 3, k1, v1); }
        toff = sbase; na2_tile(2 * p);
        if (2 * p + 1 < NT) { toff = sbase + TSZ; na2_tile(2 * p + 1); }
        if (p + 1 < NP) { LAS unsigned char* nb = lds + (STG - sbase); SWRITE1(nb, k0, v0); SWRITE1(nb + TSZ, k1, v1); }
        __syncthreads();
    }
#undef SLOAD1
#undef SWRITE1
#undef TILE_ROW
    if (hi == 0) ws[r32] = l_reg; asm volatile("s_waitcnt lgkmcnt(0)" ::: "memory");
    float rli[16];
#pragma unroll
    for (int r = 0; r < 16; ++r) rli[r] = fast_rcp(ws[crow(r, hi)]);
#pragma unroll
    for (int r = 0; r < 16; ++r) { const int q = crow(r, hi); bf16_t* orow = u.O + (size_t)((2 * pr + (q >> 4)) * 64 + 16 * g + (q & 15)) * u.ldo;
#pragma unroll
        for (int d0 = 0; d0 < 2; ++d0) { const unsigned w = cvt_pk_bf16(o[d0][r] * rli[r], 0.f); orow[d0 * 32 + r32] = (bf16_t)(w & 0xffffu); } }
    asm volatile("s_waitcnt lgkmcnt(0)" ::: "memory");
    __syncthreads();
}
#undef NA2_PK4
#undef SBAR
}

#define XB_TMO      128
#define XB_XCNT(j)  (256  + 64 * (j))
#define XB_XSUB(j)  (1280 + 64 * (j))
#define XB_XGEN(j)  (2304 + 64 * (j))
#define XB_TOP      3328
#define XB_TOPGEN   3392
#define XCD_BAR_WORDS 3456
#define XB_SPIN_CAP (1u << 22)
__device__ __forceinline__ unsigned xb_ld(unsigned* p)              { return __hip_atomic_load(p, __ATOMIC_RELAXED, __HIP_MEMORY_SCOPE_AGENT); }
__device__ __forceinline__ unsigned xb_add(unsigned* p, unsigned v) { return __hip_atomic_fetch_add(p, v, __ATOMIC_RELAXED, __HIP_MEMORY_SCOPE_AGENT); }
__device__ __forceinline__ unsigned xb_xcc_id() { return (unsigned)__builtin_amdgcn_s_getreg((3 << 11) | 20) & 0xFu; }
#define XB_SPIN(cond, bar) do { unsigned _sp = 0; while (cond) { __builtin_amdgcn_s_sleep(1); \
    if ((++_sp & 255u) == 0u) { if (xb_ld(&(bar)[XB_TMO])) break; if (_sp > XB_SPIN_CAP) { atomicAdd(&(bar)[XB_TMO], 1u); break; } } } } while (0)
struct XcdBarrier { unsigned* bar; unsigned x; volatile LAS unsigned* st; };
__device__ __forceinline__ XcdBarrier xcd_barrier_post(unsigned* bar, volatile LAS unsigned* st) {
    XcdBarrier b; b.bar = bar; b.x = xb_xcc_id(); b.st = st;
    if (threadIdx.x == 0) (void)xb_add(&bar[XB_XCNT(b.x)], 1u);
    return b;
}
__device__ __forceinline__ void xcd_barrier_complete(unsigned* bar, unsigned x, unsigned& nloc, unsigned& nx) {
    const unsigned G = gridDim.x * gridDim.y * gridDim.z;
    unsigned sum, cnt, mine, sp = 0u;
    for (;;) {
        sum = 0u; cnt = 0u; mine = 0u;
#pragma unroll
        for (unsigned j = 0; j < 16; ++j) { const unsigned c = xb_ld(&bar[XB_XCNT(j)]); sum += c; cnt += (c > 0u) ? 1u : 0u; mine = (j == x) ? c : mine; }
        if (sum == G) break;
        __builtin_amdgcn_s_sleep(1);
        if ((++sp & 255u) == 0u) { if (xb_ld(&bar[XB_TMO])) break; if (sp > XB_SPIN_CAP) { atomicAdd(&bar[XB_TMO], 1u); break; } }
    }
    nloc = mine > 0u ? mine : 1u; nx = cnt > 0u ? cnt : 1u;
}
__device__ __forceinline__ void xcd_barrier(const XcdBarrier& b) {
    asm volatile("s_waitcnt vmcnt(0)" ::: "memory");
    __syncthreads();
    if (threadIdx.x == 0) {
        unsigned* bar = b.bar;
        __builtin_amdgcn_s_waitcnt(0);
        unsigned nloc = b.st[0], nx = b.st[1];
        if (nloc == 0u) { xcd_barrier_complete(bar, b.x, nloc, nx); b.st[0] = nloc; b.st[1] = nx; }
        const unsigned old = xb_add(&bar[XB_XSUB(b.x)], 1u);
        const unsigned gen = old / nloc;
        if (old + 1u == (gen + 1u) * nloc) {
            __builtin_amdgcn_fence(__ATOMIC_RELEASE, "agent");
            asm volatile("s_waitcnt vmcnt(0)" ::: "memory");
            const unsigned og = xb_add(&bar[XB_TOP], 1u);
            const unsigned tg = og / nx;
            if (og + 1u == (tg + 1u) * nx) xb_add(&bar[XB_TOPGEN], 1u);
            else XB_SPIN(xb_ld(&bar[XB_TOPGEN]) == tg, bar);
            __builtin_amdgcn_fence(__ATOMIC_ACQUIRE, "agent");
            xb_add(&bar[XB_XGEN(b.x)], 1u);
            asm volatile("s_waitcnt vmcnt(0)" ::: "memory");
        } else {
            XB_SPIN(xb_ld(&bar[XB_XGEN(b.x)]) == gen, bar);
            __builtin_amdgcn_fence(__ATOMIC_ACQUIRE, "agent");
            asm volatile("s_waitcnt vmcnt(0)" ::: "memory");
        }
    }
    __syncthreads();
}

struct Params { const float* in[20]; float* out; unsigned char* ws; };
template <class T> __device__ __forceinline__ T* uni_ptr(T* p) {
    unsigned long long v = (unsigned long long)p; unsigned lo = __builtin_amdgcn_readfirstlane((unsigned)v), hi = __builtin_amdgcn_readfirstlane((unsigned)(v >> 32));
    typedef __attribute__((address_space(1))) T* gptr_t;
    return (T*)(gptr_t)(((unsigned long long)hi << 32) | lo); }
struct ParamsView {
    const Params* k;
    struct InView { const Params* k; __device__ __forceinline__ const float* operator[](int i) const { return uni_ptr(k->in[i]); } } in;
    float* out; unsigned char* ws;
};
__device__ __forceinline__ ParamsView kargs() { const void* k = (const void*)__builtin_amdgcn_kernarg_segment_ptr(); asm volatile("" : "+s"(k));
    ParamsView v; v.k = (const Params*)k; v.in.k = v.k; v.out = uni_ptr(v.k->out); v.ws = uni_ptr(v.k->ws); return v; }

__device__ __forceinline__ void transpose_item(const float* W, int K, int N, bf16_t* WT, int row_off, const float* scale, bool gu, int item, int lane) {
    const int nblk = N / 64, kb = item / nblk, nb = item % nblk, k0 = 64 * kb, n0 = 64 * nb;
    const int kg = lane >> 4, nq = lane & 15;
    const float* src = W + (size_t)(k0 + 16 * kg) * N + n0 + 4 * nq;
    f32x4 v[16];
#pragma unroll
    for (int i = 0; i < 16; ++i) v[i] = *(const f32x4*)(src + (size_t)i * N);
    f32x4 sc4 = (f32x4){1.f, 1.f, 1.f, 1.f};
    if (scale) sc4 = *(const f32x4*)(scale + n0 + 4 * nq);
#pragma unroll
    for (int e = 0; e < 4; ++e) {
        int drow = n0 + 4 * nq + e; if (gu) { const int jj = drow < FFH ? drow : drow - FFH; drow = (jj >> 7) * 256 + (jj & 127) + (drow < FFH ? 0 : 128); }
        bf16_t* dst = WT + (size_t)(row_off + drow) * K + k0 + 16 * kg; const float sc = sc4[e];
#pragma unroll
        for (int h = 0; h < 2; ++h) { u32x4 o;
            o.x = cvt_pk_bf16(v[8 * h + 0][e] * sc, v[8 * h + 1][e] * sc); o.y = cvt_pk_bf16(v[8 * h + 2][e] * sc, v[8 * h + 3][e] * sc);
            o.z = cvt_pk_bf16(v[8 * h + 4][e] * sc, v[8 * h + 5][e] * sc); o.w = cvt_pk_bf16(v[8 * h + 6][e] * sc, v[8 * h + 7][e] * sc);
            *(u32x4*)(dst + 8 * h) = o; }
    }
}

__device__ __forceinline__ void phase_p0(LAS unsigned char* lds) {
    const ParamsView p = kargs();
    int tid = threadIdx.x; asm volatile("" : "+v"(tid));
    const int lane = tid & 63, wave = __builtin_amdgcn_readfirstlane(tid >> 6);
    unsigned char* ws = p.ws;
    {
        LAS float* S = (LAS float*)lds;
        LAS float* R = (LAS float*)(lds + 49152);
        for (int idx = tid; idx < 9 * 1024; idx += NTHREADS) { const int cnd = idx >> 10, k = idx & 1023;
            const float v = cnd < 8 ? p.in[1][cnd * 1024 + k] : p.in[3][k]; S[k * 12 + cnd] = silu_f(v); }
        __syncthreads();
        float* MOD = (float*)(ws + WS_MOD);
        for (int item = blockIdx.x; item < 4 * 192; item += gridDim.x) {
            const int layer = item / 192, cb = item % 192; const int col0 = cb * 32 + (lane & 7) * 4;
            const int kbase = wave * 128 + (lane >> 3) * 16;
            const float* W = p.in[4] + (size_t)layer * 1024 * 6144 + col0;
            f32x4 acc[9];
#pragma unroll
            for (int c = 0; c < 9; ++c) acc[c] = (f32x4){0.f, 0.f, 0.f, 0.f};
            f32x4 wv[16];
#pragma unroll
            for (int kk = 0; kk < 16; ++kk) wv[kk] = *(const f32x4*)(W + (size_t)(kbase + kk) * 6144);
#pragma unroll
            for (int kk = 0; kk < 16; ++kk) { const int k = kbase + kk; const f32x4 w = wv[kk];
                const f32x4 s0 = *(LAS const f32x4*)(S + k * 12), s1 = *(LAS const f32x4*)(S + k * 12 + 4); const float s8 = S[k * 12 + 8];
                acc[0] += w * s0[0]; acc[1] += w * s0[1]; acc[2] += w * s0[2]; acc[3] += w * s0[3];
                acc[4] += w * s1[0]; acc[5] += w * s1[1]; acc[6] += w * s1[2]; acc[7] += w * s1[3]; acc[8] += w * s8; }
#pragma unroll
            for (int c = 0; c < 9; ++c)
#pragma unroll
                for (int e = 0; e < 4; ++e) { float v = acc[c][e]; v += __shfl_xor(v, 8); v += __shfl_xor(v, 16); v += __shfl_xor(v, 32); acc[c][e] = v; }
            if (lane < 8) {
#pragma unroll
                for (int c = 0; c < 9; ++c) *(LAS f32x4*)(R + (wave * 9 + c) * 32 + lane * 4) = acc[c]; }
            __syncthreads();
            for (int o = tid; o < 288; o += NTHREADS) { const int c = o >> 5, col = o & 31; float s = 0.f;
#pragma unroll
                for (int w = 0; w < 8; ++w) s += R[(w * 9 + c) * 32 + col];
                MOD[(size_t)(layer * 9 + c) * 6144 + cb * 32 + col] = s + p.in[5][layer * 6144 + cb * 32 + col]; }
            __syncthreads();
        }
    }
    __syncthreads();
    LAS float* scr = (LAS float*)(lds + wave * 16384);
    const int gw = blockIdx.x * NWAVES + wave, NGW = gridDim.x * NWAVES;
    {
        constexpr int I_GU = 16 * 88, I_DN = 44 * 16, I_PL = 4 * 4, I_MIN = 16 * 11, I_QB = 6 * 24, I_KVB = 4 * 32, I_MO = 16 * 16, I_NIN = 16 * 48, I_NO = 16 * 16;
        constexpr int E0 = 4 * I_GU, E1 = E0 + 4 * I_DN, E2 = E1 + 8 * I_PL, E3 = E2 + I_MIN, E4 = E3 + I_QB, E5 = E4 + I_KVB, E6 = E5 + I_MO, E7 = E6 + I_NIN, E8 = E7 + I_NO;
        for (int it = gw; it < E8; it += NGW) {
            const float* W; int K, N, row_off = 0, li; bf16_t* WT; const float* scale = nullptr; bool gu = false;
            if (it < E0) { const int l = it / I_GU; li = it - l * I_GU; W = p.in[7] + (size_t)l * DM * 2 * FFH; K = DM; N = 2 * FFH; WT = (bf16_t*)(ws + W_GU + l * SZ_GU); gu = true; }
            else if (it < E1) { const int r = it - E0, l = r / I_DN; li = r - l * I_DN; W = p.in[8] + (size_t)l * FFH * DM; K = FFH; N = DM; WT = (bf16_t*)(ws + W_DN + l * SZ_DN); }
            else if (it < E2) { const int r = it - E1, m = r / I_PL; li = r - m * I_PL; const int j = m >> 2, g = m & 3; W = p.in[9] + (size_t)m * 65536; K = 256; N = 256; WT = (bf16_t*)(ws + W_POOL + j * SZ_POOL); row_off = g * 256; scale = p.in[10] + j * 1024 + g * 256; }
            else if (it < E3) { li = it - E2; W = p.in[11]; K = 1024; N = 704; WT = (bf16_t*)(ws + W_MIN); }
            else if (it < E4) { li = it - E3; W = p.in[14]; K = 384; N = 1536; WT = (bf16_t*)(ws + W_QB); }
            else if (it < E5) { li = it - E4; W = p.in[15]; K = 256; N = 2048; WT = (bf16_t*)(ws + W_KVB); }
            else if (it < E6) { li = it - E5; W = p.in[16]; K = 1024; N = 1024; WT = (bf16_t*)(ws + W_MO); }
            else if (it < E7) { li = it - E6; W = p.in[17]; K = 1024; N = 3072; WT = (bf16_t*)(ws + W_NIN); }
            else { li = it - E7; W = p.in[19]; K = 1024; N = 1024; WT = (bf16_t*)(ws + W_NO); }
            transpose_item(W, K, N, WT, row_off, scale, gu, li, lane);
        }
    }
    { u32x4* z = (u32x4*)(ws + W_MIN + (size_t)704 * 1024 * 2); const int n16 = 64 * 1024 * 2 / 16;
      for (int i = blockIdx.x * NTHREADS + tid; i < n16; i += gridDim.x * NTHREADS) z[i] = (u32x4){0u, 0u, 0u, 0u}; }
}

struct EArgs {
    const float* xf_lat; const float* xf_ctx;
    const bf16_t* XBin;
    bf16_t* XBout; float* outf;
    const bf16_t* Y; const float* gy; const float* modg; int goff;
    bf16_t* H; const float* gh; const float* modh; int shoff, scoff;
    int M;
    const bf16_t* YP;
};
__device__ __forceinline__ void phase_enorm(const EArgs& a) {
    int tid_ = threadIdx.x; asm volatile("" : "+v"(tid_));
    const int lane = tid_ & 63, wave = __builtin_amdgcn_readfirstlane(tid_ >> 6);
    const int gw = blockIdx.x * NWAVES + wave, NGW = gridDim.x * NWAVES;
    const bool hasY = a.Y != nullptr, hasH = a.H != nullptr, srcf = a.xf_lat != nullptr;
    constexpr int RP = 2;
    const int c0 = 8 * lane;
    f32x4 xn[RP][4]; u32x4 xbn[RP][2], yn[RP][2];
#define E_LOAD(s_, r_) do { const int r__ = (r_); \
        if (srcf) { const float* xin_ = (r__ < M_LAT) ? a.xf_lat + (size_t)r__ * DM : a.xf_ctx + (size_t)(r__ - M_LAT) * DM; \
            _Pragma("unroll") for (int j = 0; j < 2; ++j) { xn[s_][2 * j] = __builtin_nontemporal_load((const f32x4*)(xin_ + c0 + 512 * j)); xn[s_][2 * j + 1] = __builtin_nontemporal_load((const f32x4*)(xin_ + c0 + 512 * j + 4)); } } \
        else { const bf16_t* xb_ = a.XBin + (size_t)r__ * DM; _Pragma("unroll") for (int j = 0; j < 2; ++j) xbn[s_][j] = __builtin_nontemporal_load((const u32x4*)(xb_ + c0 + 512 * j)); } \
        if (hasY) { const bf16_t* yr_ = a.Y + (size_t)r__ * DM; _Pragma("unroll") for (int j = 0; j < 2; ++j) yn[s_][j] = __builtin_nontemporal_load((const u32x4*)(yr_ + c0 + 512 * j)); } } while (0)
#define E_UNPK(w_, lo_, hi_) do { lo_ = (f32x4){bflo((w_).x), bfhi((w_).x), bflo((w_).y), bfhi((w_).y)}; hi_ = (f32x4){bflo((w_).z), bfhi((w_).z), bflo((w_).w), bfhi((w_).w)}; } while (0)
#pragma unroll
    for (int s = 0; s < RP; ++s) {
#pragma unroll
        for (int j = 0; j < 4; ++j) xn[s][j] = (f32x4){0.f, 0.f, 0.f, 0.f};
#pragma unroll
        for (int j = 0; j < 2; ++j) { yn[s][j] = (u32x4){0u, 0u, 0u, 0u}; xbn[s][j] = (u32x4){0u, 0u, 0u, 0u}; } }
#pragma unroll
    for (int s = 0; s < RP; ++s) { const int r = gw + s * NGW; if (r < a.M) E_LOAD(s, r); }
    f32x4 gyv[4], ghv[4], GG[4], VV[4], SS[4]; int curc = -1;
#pragma unroll
    for (int g = 0; g < 4; ++g) { const int co = c0 + 512 * (g >> 1) + 4 * (g & 1);
        gyv[g] = hasY ? *(const f32x4*)(a.gy + co) : (f32x4){0.f, 0.f, 0.f, 0.f}; ghv[g] = hasH ? *(const f32x4*)(a.gh + co) : (f32x4){0.f, 0.f, 0.f, 0.f};
        GG[g] = (f32x4){0.f, 0.f, 0.f, 0.f}; VV[g] = GG[g]; SS[g] = GG[g]; }
#define E_VEC(c_) do { if ((c_) != curc) { curc = (c_); \
        if (hasY) { const float* gt_ = a.modg + (size_t)curc * 6144 + a.goff; _Pragma("unroll") for (int g = 0; g < 4; ++g) GG[g] = *(const f32x4*)(gt_ + c0 + 512 * (g >> 1) + 4 * (g & 1)) * gyv[g]; } \
        if (hasH) { const float* sh_ = a.modh + (size_t)curc * 6144 + a.shoff; const float* sc_ = a.modh + (size_t)curc * 6144 + a.scoff; \
            _Pragma("unroll") for (int g = 0; g < 4; ++g) { const int co_ = c0 + 512 * (g >> 1) + 4 * (g & 1); VV[g] = ghv[g] * (*(const f32x4*)(sc_ + co_) + 1.0f); SS[g] = *(const f32x4*)(sh_ + co_); } } } } while (0)
    for (int row0 = gw; row0 < a.M; row0 += RP * NGW) {
        f32x4 xc[RP][4]; u32x4 yc[RP][2];
#pragma unroll
        for (int s = 0; s < RP; ++s) {
#pragma unroll
            for (int j = 0; j < 2; ++j) { f32x4 lo, hi; E_UNPK(xbn[s][j], lo, hi); xc[s][2 * j] = srcf ? xn[s][2 * j] : lo; xc[s][2 * j + 1] = srcf ? xn[s][2 * j + 1] : hi; yc[s][j] = yn[s][j]; } }
#pragma unroll
        for (int s = 0; s < RP; ++s) { const int r = row0 + (RP + s) * NGW; if (r < a.M) E_LOAD(s, r); }
#pragma unroll
        for (int s = 0; s < RP; ++s) {
            const int row = row0 + s * NGW;
            if (row < a.M) {
                const bool isl = row < M_LAT; const int cnd = isl ? (row >> 12) : 8;
                E_VEC(cnd);
                f32x4 x[4];
#pragma unroll
                for (int g = 0; g < 4; ++g) x[g] = xc[s][g];
                if (hasY) {
                    f32x4 y[4]; float ss = 0.f;
#pragma unroll
                    for (int j = 0; j < 2; ++j) E_UNPK(yc[s][j], y[2 * j], y[2 * j + 1]);
                    if (a.YP && !isl) {
#pragma unroll
                        for (int g = 0; g < 4; ++g) y[g] = (f32x4){0.f, 0.f, 0.f, 0.f};
                        for (int sl = 0; sl < 8; ++sl) { const bf16_t* yp = a.YP + ((size_t)sl * M_CTX + (row - M_LAT)) * DM;
#pragma unroll
                            for (int j = 0; j < 2; ++j) { const u32x4 w = *(const u32x4*)(yp + c0 + 512 * j); f32x4 lo, hi; E_UNPK(w, lo, hi); y[2 * j] += lo; y[2 * j + 1] += hi; } }
                    }
#pragma unroll
                    for (int g = 0; g < 4; ++g) ss += (y[g][0] * y[g][0] + y[g][1] * y[g][1]) + (y[g][2] * y[g][2] + y[g][3] * y[g][3]);
                    const float rstd = rsqrtf(wave_sum(ss) * (1.f / DM) + RMS_EPS);
#pragma unroll
                    for (int g = 0; g < 4; ++g) x[g] = x[g] + GG[g] * (y[g] * rstd);
                    if (a.outf) { float* xo = a.outf + (size_t)row * DM;
#pragma unroll
                        for (int g = 0; g < 4; ++g) __builtin_nontemporal_store(x[g], (f32x4*)(xo + c0 + 512 * (g >> 1) + 4 * (g & 1))); }
                    else { bf16_t* xo = a.XBout + (size_t)row * DM;
#pragma unroll
                        for (int j = 0; j < 2; ++j) { u32x4 w; w.x = cvt_pk_bf16(x[2 * j][0], x[2 * j][1]); w.y = cvt_pk_bf16(x[2 * j][2], x[2 * j][3]); w.z = cvt_pk_bf16(x[2 * j + 1][0], x[2 * j + 1][1]); w.w = cvt_pk_bf16(x[2 * j + 1][2], x[2 * j + 1][3]);
                            __builtin_nontemporal_store(w, (u32x4*)(xo + c0 + 512 * j));
                            E_UNPK(w, x[2 * j], x[2 * j + 1]); } }
                }
                if (hasH) {
                    float ss = 0.f;
#pragma unroll
                    for (int g = 0; g < 4; ++g) ss += (x[g][0] * x[g][0] + x[g][1] * x[g][1]) + (x[g][2] * x[g][2] + x[g][3] * x[g][3]);
                    const float rstd = rsqrtf(wave_sum(ss) * (1.f / DM) + RMS_EPS);
                    bf16_t* hr = a.H + (size_t)row * DM;
#pragma unroll
                    for (int j = 0; j < 2; ++j) { const f32x4 h0 = (x[2 * j] * rstd) * VV[2 * j] + SS[2 * j], h1 = (x[2 * j + 1] * rstd) * VV[2 * j + 1] + SS[2 * j + 1];
                        u32x4 w; w.x = cvt_pk_bf16(h0[0], h0[1]); w.y = cvt_pk_bf16(h0[2], h0[3]); w.z = cvt_pk_bf16(h1[0], h1[1]); w.w = cvt_pk_bf16(h1[2], h1[3]); *(u32x4*)(hr + c0 + 512 * j) = w; }
                }
            }
        }
    }
#undef E_LOAD
#undef E_UNPK
#undef E_VEC
}

__device__ __forceinline__ void phase_pool(const bf16_t* H, bf16_t* P, int M) {
    int tid_ = threadIdx.x; asm volatile("" : "+v"(tid_));
    const int lane = tid_ & 63, wave = __builtin_amdgcn_readfirstlane(tid_ >> 6);
    const int gw = blockIdx.x * NWAVES + wave, NGW = gridDim.x * NWAVES;
    const int per = (M + NGW - 1) / NGW;
    const int rbeg = gw * per, rend = min(rbeg + per, M);
    f32x4 S[4];
#pragma unroll
    for (int j = 0; j < 4; ++j) S[j] = (f32x4){0.f, 0.f, 0.f, 0.f};
#define LD4(r_, j_) ({ const u32x2 w_ = *(const u32x2*)(H + (size_t)(r_) * DM + 256 * (j_) + 4 * lane); (f32x4){bflo(w_.x), bfhi(w_.x), bflo(w_.y), bfhi(w_.y)}; })
    for (int row = rbeg; row < rend; ++row) {
        int seg0, L; if (row < M_LAT) { seg0 = row & ~(SEQ - 1); L = SEQ; } else { seg0 = M_LAT + ((row - M_LAT) & ~(CTXL - 1)); L = CTXL; }
        const int pos = row - seg0;
        if (row == rbeg || pos == 0) {
#pragma unroll
            for (int j = 0; j < 4; ++j) { const int half = 1 << j; f32x4 acc = (f32x4){0.f, 0.f, 0.f, 0.f};
#pragma unroll
                for (int i = 0; i < 2 * half; ++i) { const int q = pos - half + i; if (q >= 0 && q < L) acc += LD4(seg0 + q, j); }
                S[j] = acc; }
        } else {
#pragma unroll
            for (int j = 0; j < 4; ++j) { const int half = 1 << j; const int qa = pos + half - 1, qd = pos - half - 1;
                if (qa < L) S[j] += LD4(seg0 + qa, j);
                if (qd >= 0) S[j] -= LD4(seg0 + qd, j); }
        }
#pragma unroll
        for (int j = 0; j < 4; ++j) { const int half = 1 << j; const int lo = max(pos - half, 0), hi = min(pos + half, L);
            const f32x4 c = LD4(row, j); const float inv = 1.0f / (float)(hi - lo);
            const f32x4 o4 = S[j] * inv - c;
            u32x2 o; o.x = cvt_pk_bf16(o4[0], o4[1]); o.y = cvt_pk_bf16(o4[2], o4[3]);
            *(u32x2*)(P + (size_t)row * DM + 256 * j + 4 * lane) = o; }
    }
#undef LD4
}

__device__ __forceinline__ void phase_enorm_pool(const EArgs& a) {
    int tid_ = threadIdx.x; asm volatile("" : "+v"(tid_));
    const int lane = tid_ & 63, wave = __builtin_amdgcn_readfirstlane(tid_ >> 6);
    const int gw = blockIdx.x * NWAVES + wave, NGW = gridDim.x * NWAVES;
    const int M = a.M; const bf16_t* Z = a.Y;
    const int per = (M + NGW - 1) / NGW;
    const int rbeg = gw * per, rend = min(rbeg + per, M);
    constexpr int NS = 2;
    const int half_len = (per + 1) / 2;
    const bool srcf = a.xf_lat != nullptr;
    f32x4 S[NS][4];
#pragma unroll
    for (int s = 0; s < NS; ++s)
#pragma unroll
        for (int j = 0; j < 4; ++j) S[s][j] = (f32x4){0.f, 0.f, 0.f, 0.f};
    f32x4 gyv[4], ghv[4], GG[4], VV[4], SS[4]; int curc = -1;
#pragma unroll
    for (int j = 0; j < 4; ++j) { gyv[j] = *(const f32x4*)(a.gy + 4 * lane + 256 * j); ghv[j] = *(const f32x4*)(a.gh + 4 * lane + 256 * j); GG[j] = (f32x4){0.f, 0.f, 0.f, 0.f}; VV[j] = GG[j]; SS[j] = GG[j]; }
#define LD4(r_, j_) ({ const u32x2 w_ = *(const u32x2*)(Z + (size_t)(r_) * DM + 256 * (j_) + 4 * lane); (f32x4){bflo(w_.x), bfhi(w_.x), bflo(w_.y), bfhi(w_.y)}; })
    for (int i = 0; i < half_len; ++i) {
#pragma unroll
        for (int s = 0; s < NS; ++s) {
            const int row = rbeg + s * half_len + i;
            if (row < rend && (s == 1 || row < rbeg + half_len)) {
                const bool isl = row < M_LAT; const int cnd = isl ? (row >> 12) : 8;
                int seg0, L; if (isl) { seg0 = row & ~(SEQ - 1); L = SEQ; } else { seg0 = M_LAT + ((row - M_LAT) & ~(CTXL - 1)); L = CTXL; }
                const int pos = row - seg0;
                f32x4 x[4];
                if (srcf) { const float* xin = isl ? a.xf_lat + (size_t)row * DM : a.xf_ctx + (size_t)(row - M_LAT) * DM;
#pragma unroll
                    for (int j = 0; j < 4; ++j) x[j] = *(const f32x4*)(xin + 4 * lane + 256 * j); }
                else { const bf16_t* xb = a.XBin + (size_t)row * DM;
#pragma unroll
                    for (int j = 0; j < 4; ++j) { const u32x2 w = *(const u32x2*)(xb + 4 * lane + 256 * j); x[j] = (f32x4){bflo(w.x), bfhi(w.x), bflo(w.y), bfhi(w.y)}; } }
                if (i == 0 || pos == 0) {
#pragma unroll
                    for (int j = 0; j < 4; ++j) { const int half = 1 << j; f32x4 acc = (f32x4){0.f, 0.f, 0.f, 0.f};
#pragma unroll
                        for (int k = 0; k < 2 * half; ++k) { const int q = pos - half + k; if (q >= 0 && q < L) acc += LD4(seg0 + q, j); }
                        S[s][j] = acc; }
                } else {
#pragma unroll
                    for (int j = 0; j < 4; ++j) { const int half = 1 << j; const int qa = pos + half - 1, qd = pos - half - 1;
                        if (qa < L) S[s][j] += LD4(seg0 + qa, j);
                        if (qd >= 0) S[s][j] -= LD4(seg0 + qd, j); }
                }
                f32x4 y[4]; float ss = 0.f;
#pragma unroll
                for (int j = 0; j < 4; ++j) { const int half = 1 << j; const int lo = max(pos - half, 0), hi = min(pos + half, L);
                    const f32x4 c = LD4(row, j); const float inv = 1.0f / (float)(hi - lo);
                    y[j] = S[s][j] * inv - c;
                    ss += (y[j][0] * y[j][0] + y[j][1] * y[j][1]) + (y[j][2] * y[j][2] + y[j][3] * y[j][3]); }
                const float rstd = rsqrtf(wave_sum(ss) * (1.f / DM) + RMS_EPS);
                if (cnd != curc) { curc = cnd; const float* gt_ = a.modg + (size_t)cnd * 6144 + a.goff; const float* sh_ = a.modh + (size_t)cnd * 6144 + a.shoff; const float* sc_ = a.modh + (size_t)cnd * 6144 + a.scoff;
#pragma unroll
                    for (int j = 0; j < 4; ++j) { GG[j] = *(const f32x4*)(gt_ + 4 * lane + 256 * j) * gyv[j]; VV[j] = ghv[j] * (*(const f32x4*)(sc_ + 4 * lane + 256 * j) + 1.0f); SS[j] = *(const f32x4*)(sh_ + 4 * lane + 256 * j); } }
                bf16_t* xo = a.XBout + (size_t)row * DM;
                float sx = 0.f;
#pragma unroll
                for (int j = 0; j < 4; ++j) { const f32x4 xn = x[j] + GG[j] * (y[j] * rstd);
                    u32x2 w; w.x = cvt_pk_bf16(xn[0], xn[1]); w.y = cvt_pk_bf16(xn[2], xn[3]); __builtin_nontemporal_store(w, (u32x2*)(xo + 4 * lane + 256 * j));
                    x[j] = (f32x4){bflo(w.x), bfhi(w.x), bflo(w.y), bfhi(w.y)};
                    sx += (x[j][0] * x[j][0] + x[j][1] * x[j][1]) + (x[j][2] * x[j][2] + x[j][3] * x[j][3]); }
                const float rstd2 = rsqrtf(wave_sum(sx) * (1.f / DM) + RMS_EPS);
                bf16_t* hr = a.H + (size_t)row * DM;
#pragma unroll
                for (int j = 0; j < 4; ++j) { const f32x4 h = (x[j] * rstd2) * VV[j] + SS[j];
                    u32x2 w; w.x = cvt_pk_bf16(h[0], h[1]); w.y = cvt_pk_bf16(h[2], h[3]); *(u32x2*)(hr + 4 * lane + 256 * j) = w; }
            }
        }
    }
#undef LD4
}

__device__ __forceinline__ void phase_emla(const bf16_t* A, bf16_t* QA, bf16_t* KVA, bf16_t* KR, const float* gq, const float* gkv) {
    int tid_ = threadIdx.x; asm volatile("" : "+v"(tid_));
    const int lane = tid_ & 63, wave = __builtin_amdgcn_readfirstlane(tid_ >> 6);
    const int gw = blockIdx.x * NWAVES + wave, NGW = gridDim.x * NWAVES;
    float g0[8], g1[8];
#pragma unroll
    for (int i = 0; i < 8; ++i) { g0[i] = lane < 48 ? gq[lane * 8 + i] : gkv[(lane - 48) * 8 + i]; g1[i] = lane < 16 ? gkv[128 + lane * 8 + i] : 1.f; }
    for (int row = gw; row < M_ALL; row += NGW) {
        const bf16_t* ar = A + (size_t)row * 768;
        const bf16x8 v0 = *(const bf16x8*)(ar + lane * 8);
        bf16x8 v1 = (bf16x8){0, 0, 0, 0, 0, 0, 0, 0};
        if (lane < 24) v1 = *(const bf16x8*)(ar + 512 + lane * 8);
        float f0[8], f1[8]; float ss0 = 0.f, ss1 = 0.f;
#pragma unroll
        for (int i = 0; i < 8; ++i) { f0[i] = bf2f((unsigned short)v0[i]); f1[i] = bf2f((unsigned short)v1[i]); ss0 += f0[i] * f0[i]; ss1 += f1[i] * f1[i]; }
        const float sq = wave_sum(lane < 48 ? ss0 : 0.f);
        const float skv = wave_sum((lane >= 48 ? ss0 : 0.f) + (lane < 16 ? ss1 : 0.f));
        const float rq = rsqrtf(sq * (1.f / 384.f) + RMS_EPS), rkv = rsqrtf(skv * (1.f / 256.f) + RMS_EPS);
        float oth[8];
#pragma unroll
        for (int i = 0; i < 8; ++i) oth[i] = __shfl_xor(f1[i], 4);
        float ov[8];
        if (lane < 48) {
#pragma unroll
            for (int i = 0; i < 8; ++i) ov[i] = f0[i] * rq * g0[i];
            u32x4 w; w.x = cvt_pk_bf16(ov[0], ov[1]); w.y = cvt_pk_bf16(ov[2], ov[3]); w.z = cvt_pk_bf16(ov[4], ov[5]); w.w = cvt_pk_bf16(ov[6], ov[7]);
            *(u32x4*)(QA + (size_t)row * 384 + lane * 8) = w;
        } else {
#pragma unroll
            for (int i = 0; i < 8; ++i) ov[i] = f0[i] * rkv * g0[i];
            u32x4 w; w.x = cvt_pk_bf16(ov[0], ov[1]); w.y = cvt_pk_bf16(ov[2], ov[3]); w.z = cvt_pk_bf16(ov[4], ov[5]); w.w = cvt_pk_bf16(ov[6], ov[7]);
            *(u32x4*)(KVA + (size_t)row * 256 + (lane - 48) * 8) = w;
        }
        if (lane < 16) {
#pragma unroll
            for (int i = 0; i < 8; ++i) ov[i] = f1[i] * rkv * g1[i];
            u32x4 w; w.x = cvt_pk_bf16(ov[0], ov[1]); w.y = cvt_pk_bf16(ov[2], ov[3]); w.z = cvt_pk_bf16(ov[4], ov[5]); w.w = cvt_pk_bf16(ov[6], ov[7]);
            *(u32x4*)(KVA + (size_t)row * 256 + 128 + lane * 8) = w;
        } else if (lane < 24) {
            const int c = lane - 16;
            if (row < M_LAT) {
                const int t = row & (SEQ - 1); const float grow = (float)(t >> 6), gcol = (float)(t & 63);
#pragma unroll
                for (int i = 0; i < 8; ++i) { const int ii = (c & 3) * 8 + i; const float pos = ii < 16 ? grow : gcol;
                    const float inv = __builtin_amdgcn_exp2f(-(float)(ii & 15) * 0.8304820237218406f);
                    const float ang = pos * inv; const float cs = __cosf(ang), sn = __sinf(ang);
                    ov[i] = (c < 4) ? (f1[i] * cs - oth[i] * sn) : (oth[i] * sn + f1[i] * cs); }
            } else {
#pragma unroll
                for (int i = 0; i < 8; ++i) ov[i] = f1[i];
            }
            u32x4 w; w.x = cvt_pk_bf16(ov[0], ov[1]); w.y = cvt_pk_bf16(ov[2], ov[3]); w.z = cvt_pk_bf16(ov[4], ov[5]); w.w = cvt_pk_bf16(ov[6], ov[7]);
            *(u32x4*)(KR + (size_t)row * 64 + c * 8) = w;
        }
    }
}

__device__ __forceinline__ int vcu_of(int bx, int G) { return (G % 8 == 0) ? (bx % 8) * (G / 8) + bx / 8 : bx; }

__device__ __forceinline__ void phase_attn_mla(unsigned char* ws, unsigned char* hb, LAS unsigned char* lds) {
    const int G = gridDim.x, vcu = vcu_of(blockIdx.x, G);
    const bf16_t* Q = (const bf16_t*)(ws + S_Q); const bf16_t* KV = (const bf16_t*)(ws + S_KV); const bf16_t* KR = (const bf16_t*)(ws + Y_KR); bf16_t* O = (bf16_t*)(hb + H_O);
    const float C = 0.07216878364870322f * LOG2E;
    for (int un = vcu; un < 1024 + 64; un += G) {
        att::AttnU u;
        int b, h, qrow0;
        if (un < 1024) { b = un >> 7; h = (un >> 4) & 7; const int qb = un & 15; qrow0 = b * SEQ + qb * 256; u.rope_pos0 = qb * 256; u.NT = 4 + 64; }
        else { const int c = un - 1024; b = c >> 3; h = c & 7; qrow0 = M_LAT + b * CTXL; u.rope_pos0 = -1; u.NT = 4; }
        u.Qw = Q + (size_t)qrow0 * 1536 + h * 192; u.ldq = 1536;
        u.K0 = KV + h * 256; u.ldk0 = 2048; u.K2 = KR; u.ldk2 = 64; u.V = KV + h * 256 + 128; u.ldv = 2048;
        u.O = O + (size_t)qrow0 * 1024 + h * 128; u.ldo = 1024;
        u.baseA = M_LAT + b * CTXL; u.nA = 4; u.baseB = b * SEQ;
        u.lo = 0; u.r0 = 0; u.rpb_h = nullptr;
        att::attn_unit<12, 4, 0>(lds, u, C);
    }
}
__device__ __forceinline__ void phase_attn_na(unsigned char* ws, unsigned char* hb, const float* rpb, LAS unsigned char* lds) {
    const int G = gridDim.x, vcu = vcu_of(blockIdx.x, G);
    const bf16_t* Qb = (const bf16_t*)(ws + S_QKV); const bf16_t* Kp = Qb + (size_t)M_ALL * 1024; const bf16_t* Vp = Kp + (size_t)128 * 4352 * 64; bf16_t* O = (bf16_t*)(hb + H_O);
    const float C = 0.125f * LOG2E;
    for (int un = vcu; un < 2048; un += G) {
        att::AttnU u;
        const int b = un >> 8, h = (un >> 4) & 15, rg = un & 15; const int r0 = rg * 4;
        const int lo = min(max(r0 - 4, 0), 56), hiE = min(max(r0 + 3 - 4, 0), 56) + 8;
        const int qrow0 = b * SEQ + r0 * 64;
        u.Qw = Qb + (size_t)qrow0 * 1024 + h * 64; u.ldq = 1024;
        u.K0 = Kp + (size_t)(b * 16 + h) * 4352 * 64; u.ldk0 = 64; u.K2 = nullptr; u.ldk2 = 0; u.V = Vp + (size_t)(b * 16 + h) * 4352 * 64; u.ldv = 64;
        u.O = O + (size_t)qrow0 * 1024 + h * 64; u.ldo = 1024;
        u.baseA = lo * 64; u.nA = hiE - lo; u.baseB = 4096; u.NT = u.nA + 4;
        u.rope_pos0 = -1; u.lo = lo; u.r0 = r0; u.rpb_h = rpb + h * 465;
        att::attn_unit_na2(lds, u, C);
    }
}

#ifdef SITE_MASK
#define GEMM_SITE(i, call) do { if ((SITE_MASK >> (i)) & 1) { call; } } while (0)
#else
#define GEMM_SITE(i, call) call
#endif
constexpr int LDS_BYTES = 147456;
constexpr int MISC_OFF = 131072 + 320;

__device__ __forceinline__ void run_enorm(int layer, int which  , int Mrows) {
    const ParamsView p = kargs(); unsigned char* ws = p.ws;
    const float* MOD = (const float*)(ws + WS_MOD); const float* norm_g = p.in[6];
    bf16_t* Hb = (bf16_t*)p.out; bf16_t* Yb = (bf16_t*)(ws + WS_Y); bf16_t* XB = (bf16_t*)(ws + WS_X);
    const float* ng = norm_g + layer * 4 * DM; const float* modl = MOD + (size_t)layer * 9 * 6144;
    EArgs a; a.xf_lat = nullptr; a.xf_ctx = nullptr; a.XBin = XB; a.XBout = XB; a.outf = nullptr; a.Y = Yb; a.modg = modl; a.H = Hb; a.modh = modl; a.M = Mrows; a.YP = nullptr;
    if (which == 0) { a.xf_lat = p.in[0]; a.xf_ctx = p.in[2]; a.Y = nullptr; a.gy = ng; a.goff = 0; a.gh = ng; a.shoff = 0; a.scoff = DM; }
    else if (which == 1) { if (layer == 0) { a.xf_lat = p.in[0]; a.xf_ctx = p.in[2]; } if (layer % 3 == 1) a.YP = (const bf16_t*)((unsigned char*)p.out + HB_YP); a.gy = ng + DM; a.goff = 2 * DM; a.gh = ng + 2 * DM; a.shoff = 3 * DM; a.scoff = 4 * DM; }
    else { if (Mrows == M_ALL) a.YP = (const bf16_t*)((unsigned char*)p.out + HB_YP);
           a.gy = ng + 3 * DM; a.goff = 5 * DM; if (layer == 3) { a.H = nullptr; a.outf = p.out; } a.gh = ng + 4 * DM; a.modh = modl + 9 * 6144; a.shoff = 0; a.scoff = DM; }
    if (which == 1 && (layer % 3) == 0) phase_enorm_pool(a); else phase_enorm(a);
}
__device__ __forceinline__ void run_gemm(int layer, int gid, int Mrows, LAS unsigned char* lds) {
    const ParamsView p = kargs(); unsigned char* ws = p.ws;
    unsigned char* hb = (unsigned char*)p.out; bf16_t* Hb = (bf16_t*)hb; bf16_t* Yb = (bf16_t*)(ws + WS_Y);
    pg8::Gemm g; bf16_t* GO; int gldc; int swi = 0;
    switch (gid) {
    case 0: g = pg8::Gemm{Hb, (const bf16_t*)(ws + W_GU + layer * SZ_GU), Mrows, 2 * FFH, 1024, 1024, 1024, 0}; GO = (bf16_t*)(ws + S_ACT); gldc = FFH; swi = 1; break;
    case 1: g = pg8::Gemm{(const bf16_t*)(ws + S_ACT), (const bf16_t*)(ws + W_DN + layer * SZ_DN), Mrows, 1024, FFH, FFH, FFH, 0}; GO = Yb; gldc = 1024; break;
    case 2: g = pg8::Gemm{Hb, (const bf16_t*)(ws + W_POOL + (layer / 3) * SZ_POOL), Mrows, 1024, 256, 1024, 256, 256}; GO = Yb; gldc = 1024; break;
    case 3: g = pg8::Gemm{Hb, (const bf16_t*)(ws + W_MIN), M_ALL, 768, 1024, 1024, 1024, 0}; GO = (bf16_t*)(ws + Y_A); gldc = 768; break;
    case 4: g = pg8::Gemm{(const bf16_t*)(hb + H_QA), (const bf16_t*)(ws + W_QB), M_ALL, 1536, 384, 384, 384, 0}; GO = (bf16_t*)(ws + S_Q); gldc = 1536; break;
    case 5: g = pg8::Gemm{(const bf16_t*)(hb + H_KVA), (const bf16_t*)(ws + W_KVB), M_ALL, 2048, 256, 256, 256, 0}; GO = (bf16_t*)(ws + S_KV); gldc = 2048; break;
    case 6: g = pg8::Gemm{(const bf16_t*)(hb + H_O), (const bf16_t*)(ws + W_MO), M_ALL, 1024, 1024, 1024, 1024, 0}; GO = Yb; gldc = 1024; break;
    case 7: g = pg8::Gemm{Hb, (const bf16_t*)(ws + W_NIN), M_ALL, 3072, 1024, 1024, 1024, 0}; GO = (bf16_t*)(ws + S_QKV); gldc = 1024; swi = 2; break;
    default: g = pg8::Gemm{(const bf16_t*)(hb + H_O), (const bf16_t*)(ws + W_NO), M_LAT, 1024, 1024, 1024, 1024, 0}; GO = Yb; gldc = 1024; break;
    }
    const bool split = ((gid == 1) && (Mrows == M_ALL)) || (gid == 6);
    const int nrep = split ? 9 : 1; const int G = (int)gridDim.x; int cidx = (int)blockIdx.x;
    if (split) g.M = M_LAT;
    for (int rep = 0; rep < nrep; ++rep) {
        if (rep > 0) { const int sl = rep - 1;
            if (gid == 1) { const int k0 = sl < 6 ? 384 * sl : 2304 + 256 * (sl - 6); const int Ks = sl < 6 ? 384 : 256;
                g = pg8::Gemm{(const bf16_t*)(ws + S_ACT) + (size_t)M_LAT * FFH + k0, (const bf16_t*)(ws + W_DN + layer * SZ_DN) + k0, M_CTX, 1024, Ks, FFH, FFH, 0}; }
            else { const int k0 = 128 * sl;
                g = pg8::Gemm{(const bf16_t*)(hb + H_O) + (size_t)M_LAT * DM + k0, (const bf16_t*)(ws + W_MO) + k0, M_CTX, 1024, 128, 1024, 1024, 0}; }
            GO = (bf16_t*)(hb + HB_YP) + (size_t)sl * M_CTX * DM; gldc = 1024; cidx = ((int)blockIdx.x + G - (G / 8) * sl) % G; }
        pg8::gemm_phase(lds, g, G, cidx, GO, gldc, swi);
    }
}

__global__ void __launch_bounds__(NTHREADS, 2) mega_fwd(Params p_unused) {
    extern __shared__ __attribute__((aligned(16))) unsigned char lds_raw[];
    LAS unsigned char* lds = (LAS unsigned char*)lds_raw;
    cg::grid_group grid = cg::this_grid();
    const int tid = threadIdx.x;
    for (int u = tid; u < (LDS_BYTES - 131072) / 4; u += NTHREADS) ((LAS unsigned*)(lds + 131072))[u] = 0u;
    __syncthreads();
#if USE_CG_SYNC
#define GRID_BAR() grid.sync()
#else
    { XcdBarrier b0 = xcd_barrier_post((unsigned*)(kargs().ws + WS_CTL) + 64, (volatile LAS unsigned*)(lds + MISC_OFF) + 8); (void)b0; }
#define GRID_BAR() do { XcdBarrier b_; b_.bar = (unsigned*)(kargs().ws + WS_CTL) + 64; b_.x = xb_xcc_id(); b_.st = (volatile LAS unsigned*)(lds + MISC_OFF) + 8; xcd_barrier(b_); } while (0)
#endif
#ifndef NO_P0
    phase_p0(lds);
#endif
    grid.sync();
    run_enorm(0, 0, M_ALL);
    GRID_BAR();

    for (int layer = 0; layer < 4; ++layer) {
        const int kind = layer % 3;
        const int Mrows = layer >= 2 ? M_LAT : M_ALL;
        const int nsteps = kind == 0 ? 5 : (kind == 1 ? 10 : 7);
        for (int s = 0; s < nsteps; ++s) {
            const int t = s - (nsteps - 4);
            int op; bool sync_after = true;
            if (t >= 0) { op = t == 0 ? 10 : (t == 1 ? 0 : (t == 2 ? 1 : 11)); if (t == 3 && layer == 3) sync_after = false; }
            else if (kind == 0) op = 2;
            else if (kind == 1) { op = s == 0 ? 3 : (s == 1 ? 13 : (s == 2 ? 4 : (s == 3 ? 5 : (s == 4 ? 14 : 6)))); if (s == 2) sync_after = false; }
            else op = s == 0 ? 7 : (s == 1 ? 15 : 8);
            if (op < 9) run_gemm(layer, op, Mrows, lds);
            else if (op == 10) run_enorm(layer, 1, Mrows);
            else if (op == 11) run_enorm(layer, 2, Mrows);
            else if (op == 12) { const ParamsView p = kargs(); phase_pool((const bf16_t*)p.out, (bf16_t*)(p.ws + S_P), Mrows); }
            else if (op == 13) { const ParamsView p = kargs(); unsigned char* ws = p.ws; phase_emla((const bf16_t*)(ws + Y_A), (bf16_t*)((unsigned char*)p.out + H_QA), (bf16_t*)((unsigned char*)p.out + H_KVA), (bf16_t*)(ws + Y_KR), p.in[12], p.in[13]); }
#ifndef NO_ATT_MLA
            else if (op == 14) { const ParamsView p = kargs(); phase_attn_mla(p.ws, (unsigned char*)p.out, lds); }
#endif
#ifndef NO_ATT_NA
            else if (op == 15) { const ParamsView p = kargs(); phase_attn_na(p.ws, (unsigned char*)p.out, p.in[18], lds); }
#endif
            if (sync_after) GRID_BAR();
        }
    }
}

extern "C" void kernel_launch(void* const* d_in, const int* in_sizes, int n_in, void* d_out, int out_size, void* d_ws, size_t ws_size, hipStream_t stream) {
    static int grid = 0;
    if (grid == 0) {
        if (n_in != 20 || out_size != M_LAT * DM || ws_size < WS_END) { fprintf(stderr, "kernel_launch: unexpected shapes: n_in %d out %d ws %zu (need %zu)\n", n_in, out_size, ws_size, (size_t)WS_END); grid = -1; return; }
        int dev = 0, cus = 0, per_cu = 0;
        if (hipGetDevice(&dev) != hipSuccess || hipDeviceGetAttribute(&cus, hipDeviceAttributeMultiprocessorCount, dev) != hipSuccess) { grid = -1; return; }
        if (hipFuncSetAttribute((const void*)mega_fwd, hipFuncAttributeMaxDynamicSharedMemorySize, LDS_BYTES) != hipSuccess) { fprintf(stderr, "kernel_launch: hipFuncSetAttribute failed\n"); grid = -1; return; }
        if (hipOccupancyMaxActiveBlocksPerMultiprocessor(&per_cu, (const void*)mega_fwd, NTHREADS, LDS_BYTES) != hipSuccess || per_cu < 1) { fprintf(stderr, "kernel_launch: occupancy query says %d\n", per_cu); per_cu = 1; }
        (void)hipGetLastError();
        grid = cus;
    }
    if (grid < 0) return;
    (void)hipMemsetAsync((char*)d_ws + WS_CTL, 0, CTL_BYTES, stream);
    Params p{};
    for (int i = 0; i < 20; ++i) p.in[i] = (const float*)d_in[i];
    p.out = (float*)d_out; p.ws = (unsigned char*)d_ws;
    void* args[] = {&p};
    hipError_t e = hipLaunchCooperativeKernel((const void*)mega_fwd, dim3(grid), dim3(NTHREADS), args, LDS_BYTES, stream);
    if (e != hipSuccess) fprintf(stderr, "kernel_launch: cooperative launch failed: %s (grid %d)\n", hipGetErrorString(e), grid);
}
```

```cpp
#include <hip/hip_runtime.h>
#include <hip/hip_cooperative_groups.h>
#include <cstdio>
#include <cstdint>
namespace cg = cooperative_groups;

#define LAS __attribute__((address_space(3)))
typedef unsigned short bf16_t;
typedef short bf16x8 __attribute__((ext_vector_type(8)));
typedef short s16x4 __attribute__((ext_vector_type(4)));
typedef float f32x4 __attribute__((ext_vector_type(4)));
typedef float f32x16 __attribute__((ext_vector_type(16)));
typedef unsigned u32x4 __attribute__((ext_vector_type(4)));
typedef unsigned u32x2 __attribute__((ext_vector_type(2)));

#ifndef USE_CG_SYNC
#define USE_CG_SYNC 0
#endif

constexpr int DM = 1024, NB = 8, SEQ = 4096, CTXL = 256, FFH = 2816;
constexpr int M_LAT = NB * SEQ;
constexpr int M_CTX = NB * CTXL;
constexpr int M_ALL = M_LAT + M_CTX;
constexpr float RMS_EPS = 1e-6f;
constexpr float LOG2E = 1.4426950408889634f;
constexpr int NWAVES = 8, NTHREADS = 512;

constexpr size_t MiB = 1u << 20;
constexpr size_t WS_CTL = 0;
constexpr size_t CTL_BYTES = 65536;
constexpr size_t WS_MOD = 65536;
constexpr size_t WS_W = 1 * MiB;
constexpr size_t SZ_GU = (size_t)2 * FFH * DM * 2, SZ_DN = (size_t)DM * FFH * 2, SZ_POOL = (size_t)DM * 256 * 2;
constexpr size_t W_GU = WS_W, W_DN = W_GU + 4 * SZ_GU, W_POOL = W_DN + 4 * SZ_DN, W_MIN = W_POOL + 2 * SZ_POOL;
constexpr size_t W_QB = W_MIN + (size_t)768 * 1024 * 2, W_KVB = W_QB + (size_t)1536 * 384 * 2, W_MO = W_KVB + (size_t)2048 * 256 * 2;
constexpr size_t W_NIN = W_MO + (size_t)1024 * 1024 * 2, W_NO = W_NIN + (size_t)3072 * 1024 * 2, W_END = W_NO + (size_t)1024 * 1024 * 2;
static_assert(W_END <= 83 * MiB, "weights");
constexpr size_t WS_X = 91 * MiB;
constexpr size_t WS_Y = 159 * MiB;
constexpr size_t WS_S = 227 * MiB;
constexpr size_t WS_END = 465 * MiB;
constexpr size_t S_ACT = WS_S;
constexpr size_t S_P = WS_S;
constexpr size_t S_Q = WS_S;
constexpr size_t S_KV = WS_S + 102 * MiB;
constexpr size_t Y_A = WS_Y;
constexpr size_t Y_KR = WS_Y + 51 * MiB;
constexpr size_t H_QA = 0;
constexpr size_t H_KVA = (size_t)M_ALL * 384 * 2;
constexpr size_t H_O = 0;
constexpr size_t HB_YP = 72 * MiB;
constexpr size_t S_QKV = WS_S;

__device__ __forceinline__ unsigned cvt_pk_bf16(float lo, float hi) { unsigned r; asm volatile("v_cvt_pk_bf16_f32 %0, %1, %2" : "=v"(r) : "v"(lo), "v"(hi)); return r; }
__device__ __forceinline__ float bf2f(unsigned short s) { return __uint_as_float(((unsigned)s) << 16); }
__device__ __forceinline__ float bflo(unsigned w) { return __uint_as_float(w << 16); }
__device__ __forceinline__ float bfhi(unsigned w) { return __uint_as_float(w & 0xffff0000u); }
__device__ __forceinline__ float wave_sum(float v) {
#pragma unroll
    for (int o = 1; o < 64; o <<= 1) v += __shfl_xor(v, o);
    return v;
}
__device__ __forceinline__ float fast_rcp(float x) { return __builtin_amdgcn_rcpf(x); }
__device__ __forceinline__ float silu_f(float x) { return x * fast_rcp(1.0f + __builtin_amdgcn_exp2f(-x * LOG2E)); }

namespace pg8 {
constexpr int BM = 256, BK = 64, HALF = 128, HTB = HALF * BK * 2, STAGE_BYTES = 8 * HTB, NXCD = 8, WGM = 8;
__host__ __device__ __forceinline__ int lds_byte(int r, int c) { const int st = (r >> 4) * 2 + (c >> 5), rr = r & 15, cc = c & 31, ob = rr * 64 + cc * 2; return st * 1024 + (ob ^ (((ob >> 9) & 1) << 5)); }
__host__ __device__ __forceinline__ void stage_rc(int b, int& R, int& C) { const int st = b / 1024, sb = b % 1024, swz = sb ^ (((sb >> 9) & 1) << 5); R = (st >> 1) * 16 + swz / 64; C = (st & 1) * 32 + (swz % 64) / 2; }
__host__ __device__ __forceinline__ int perm32(int rho) { const int n = rho >> 4, i = rho & 15; return 8 * (i >> 2) + 4 * n + (i & 3); }

struct Unit { int pm, pn; };
struct Gemm { const bf16_t* A; const bf16_t* Bt; int M, N, K, lda, ldb, apn; };

struct StaticOrder {
    int nM, nN, nwg, G, c;
    __device__ void init(int M, int N, int G_, int c_) { nM = M / BM; nN = N / BM; nwg = nM * nN; G = G_; c = c_; }
    __device__ bool next(int i, Unit& u) const {
        const long L = (long)i * G + c; if (L >= nwg) return false;
        int wgid = (int)L; { const int q = nwg / NXCD, r = nwg % NXCD, xcd = wgid % NXCD, off = wgid / NXCD; wgid = (xcd < r ? xcd * (q + 1) : r * (q + 1) + (xcd - r) * q) + off; }
        const int nig = WGM * nN, gid = wgid / nig, fm = gid * WGM, gsz = (nM - fm) < WGM ? (nM - fm) : WGM;
        u.pm = fm + ((wgid % nig) % gsz); u.pn = (wgid % nig) / gsz; return true;
    }
};

struct EpiStore {
    bf16_t* O; int ldc;
    __device__ __forceinline__ void operator()(const f32x4 (&acc)[2][2][4][2], const Unit& u, int wr, int wc, int fr, int fq) const {
        const int row0 = u.pm * BM + wr * 64 + fr; const int col0 = u.pn * BM + wc * 32 + 8 * fq;
#pragma unroll
        for (int ai = 0; ai < 2; ++ai)
#pragma unroll
            for (int m = 0; m < 4; ++m) { bf16_t* rowp = O + (size_t)(row0 + ai * HALF + m * 16) * ldc + col0;
#pragma unroll
                for (int bj = 0; bj < 2; ++bj) { const f32x4 v0 = acc[ai][bj][m][0], v1 = acc[ai][bj][m][1];
                    u32x4 w; w.x = cvt_pk_bf16(v0[0], v0[1]); w.y = cvt_pk_bf16(v0[2], v0[3]); w.z = cvt_pk_bf16(v1[0], v1[1]); w.w = cvt_pk_bf16(v1[2], v1[3]);
                    *(u32x4*)(rowp + bj * HALF) = w; } }
    }
};
struct EpiSwiGLU {
    bf16_t* O; int ldc;
    __device__ __forceinline__ void operator()(const f32x4 (&acc)[2][2][4][2], const Unit& u, int wr, int wc, int fr, int fq) const {
        const int row0 = u.pm * BM + wr * 64 + fr; const int col0 = u.pn * HALF + wc * 32 + 8 * fq;
#pragma unroll
        for (int ai = 0; ai < 2; ++ai)
#pragma unroll
            for (int m = 0; m < 4; ++m) { bf16_t* rowp = O + (size_t)(row0 + ai * HALF + m * 16) * ldc + col0;
                const f32x4 g0 = acc[ai][0][m][0], g1 = acc[ai][0][m][1], u0 = acc[ai][1][m][0], u1 = acc[ai][1][m][1];
                u32x4 w; w.x = cvt_pk_bf16(silu_f(g0[0]) * u0[0], silu_f(g0[1]) * u0[1]); w.y = cvt_pk_bf16(silu_f(g0[2]) * u0[2], silu_f(g0[3]) * u0[3]);
                w.z = cvt_pk_bf16(silu_f(g1[0]) * u1[0], silu_f(g1[1]) * u1[1]); w.w = cvt_pk_bf16(silu_f(g1[2]) * u1[2], silu_f(g1[3]) * u1[3]);
                *(u32x4*)rowp = w; }
    }
};

struct EpiNA {
    bf16_t* Q; bf16_t* Kp; bf16_t* Vp;
    __device__ __forceinline__ void operator()(const f32x4 (&acc)[2][2][4][2], const Unit& u, int wr, int wc, int fr, int fq) const {
        const int row0 = u.pm * BM + wr * 64 + fr; const int sect = u.pn >> 2; const int cin0 = (u.pn & 3) * BM + wc * 32 + 8 * fq;
        bf16_t* plane = sect == 1 ? Kp : Vp;
#pragma unroll
        for (int ai = 0; ai < 2; ++ai)
#pragma unroll
            for (int m = 0; m < 4; ++m) { const int row = row0 + ai * HALF + m * 16;
                const bool isl = row < 32768; const int b = isl ? (row >> 12) : ((row - 32768) >> 8); const int tall = isl ? (row & 4095) : 4096 + ((row - 32768) & 255);
#pragma unroll
                for (int bj = 0; bj < 2; ++bj) { const f32x4 v0 = acc[ai][bj][m][0], v1 = acc[ai][bj][m][1]; const int cin = cin0 + bj * HALF;
                    u32x4 w; w.x = cvt_pk_bf16(v0[0], v0[1]); w.y = cvt_pk_bf16(v0[2], v0[3]); w.z = cvt_pk_bf16(v1[0], v1[1]); w.w = cvt_pk_bf16(v1[2], v1[3]);
                    bf16_t* dst = sect == 0 ? Q + (size_t)row * 1024 + cin : plane + ((size_t)(b * 16 + (cin >> 6)) * 4352 + tall) * 64 + (cin & 63);
                    *(u32x4*)dst = w; } }
    }
};
__device__ __forceinline__ void gemm_phase(LAS unsigned char* lds, const Gemm g, int G, int cidx, bf16_t* O, int ldc, int emode) {
#ifdef NO_GEMM
    return;
#endif
    StaticOrder S; S.init(g.M, g.N, G, cidx);
    int tid = threadIdx.x; asm volatile("" : "+v"(tid));
    const int wid = __builtin_amdgcn_readfirstlane(tid >> 6), lane = tid & 63, wr = wid >> 2, wc = wid & 3, fr = lane & 15, fq = lane >> 4;
    const int K = g.K, nt = K / BK;
    unsigned voffA[2], voffB[2];
#pragma unroll
    for (int i = 0; i < 2; ++i) { int R, C; stage_rc(tid * 16 + i * 8192, R, C); const int Rb = (R & ~31) + perm32(R & 31);
        voffA[i] = (unsigned)(R * g.lda + C) * 2u; voffB[i] = (unsigned)(Rb * g.ldb + C) * 2u; }
    const size_t kstep = (size_t)(BK * 2);
    const size_t hstepA = (size_t)HALF * g.lda * 2, hstepB = (size_t)HALF * g.ldb * 2;
    const size_t tstepA = 2 * hstepA, tstepB = 2 * hstepB;
    const size_t apnB = (size_t)g.apn * 2;
    const unsigned ldsw = (unsigned)wid * 1024u;
    const int aoff = lds_byte(wr * 64 + fr, fq * 8), boff = lds_byte(wc * 32 + fr, fq * 8);
#define PG8_SA(b, h) (((b) * 2 + (h)) * HTB)
#define PG8_SB(b, h) ((4 + (b) * 2 + (h)) * HTB)
#define PG8_STAGE(bufoff, gbase, voff) do { _Pragma("unroll") for (int _i = 0; _i < 2; ++_i) \
        __builtin_amdgcn_global_load_lds((const unsigned*)((const char*)(gbase) + (voff)[_i]), (LAS unsigned*)(lds + (bufoff) + ldsw + _i * 8192), 16, 0, 0); } while (0)
#define PG8_LDA(dst, b, h) do { _Pragma("unroll") for (int m = 0; m < 4; ++m) _Pragma("unroll") for (int k = 0; k < 2; ++k) dst[m][k] = *(const LAS bf16x8*)(lds + PG8_SA(b, h) + aoff + m * 2048 + k * 1024); } while (0)
#define PG8_LDB(dst, b, h) do { _Pragma("unroll") for (int n = 0; n < 2; ++n) _Pragma("unroll") for (int k = 0; k < 2; ++k) dst[n][k] = *(const LAS bf16x8*)(lds + PG8_SB(b, h) + boff + n * 2048 + k * 1024); } while (0)
#define PG8_MMA(ai, bj, At, Bt) do { __builtin_amdgcn_s_setprio(1); _Pragma("unroll") for (int m = 0; m < 4; ++m) _Pragma("unroll") for (int n = 0; n < 2; ++n) _Pragma("unroll") for (int k = 0; k < 2; ++k) \
        acc[ai][bj][m][n] = __builtin_amdgcn_mfma_f32_16x16x32_bf16(Bt[n][k], At[m][k], acc[ai][bj][m][n], 0, 0, 0); __builtin_amdgcn_s_setprio(0); } while (0)
#define PG8_WAIT_V(n) asm volatile("s_waitcnt vmcnt(" #n ")" ::: "memory")
#define PG8_WAIT_L(n) asm volatile("s_waitcnt lgkmcnt(" #n ")" ::: "memory")
#define PG8_BAR __builtin_amdgcn_s_barrier()
#define PG8_SCHED __builtin_amdgcn_sched_barrier(0)
    Unit cur, nxt; int ui = 0;
    if (!S.next(0, cur)) return;
    f32x4 acc[2][2][4][2];
#pragma unroll
    for (int a = 0; a < 2; ++a)
#pragma unroll
        for (int b = 0; b < 2; ++b)
#pragma unroll
            for (int m = 0; m < 4; ++m)
#pragma unroll
                for (int n = 0; n < 2; ++n) acc[a][b][m][n] = (f32x4){0.f, 0.f, 0.f, 0.f};
    bf16x8 At[4][2], B0[2][2], B1[2][2];
    const char* cA = (const char*)g.A + (size_t)cur.pm * tstepA + (size_t)cur.pn * apnB; const char* cB = (const char*)g.Bt + (size_t)cur.pn * tstepB;
    PG8_STAGE(PG8_SB(0, 0), cB, voffB); PG8_STAGE(PG8_SB(0, 1), cB + hstepB, voffB); PG8_STAGE(PG8_SA(0, 0), cA, voffA); PG8_STAGE(PG8_SA(0, 1), cA + hstepA, voffA);
    if (wr == 1) PG8_BAR;
    PG8_WAIT_V(2); PG8_BAR;
    PG8_STAGE(PG8_SB(1, 0), cB + kstep, voffB); PG8_STAGE(PG8_SA(1, 0), cA + kstep, voffA); PG8_STAGE(PG8_SB(1, 1), cB + hstepB + kstep, voffB);
    PG8_WAIT_V(6); PG8_BAR;
    for (;;) {
        const bool has_next = S.next(ui + 1, nxt);
        const char* nA = has_next ? (const char*)g.A + (size_t)nxt.pm * tstepA + (size_t)nxt.pn * apnB : cA; const char* nB = has_next ? (const char*)g.Bt + (size_t)nxt.pn * tstepB : cB;
        for (int t = 0; t < nt; t += 2) {
            const bool last = (t == nt - 2);
            const char* a1 = cA + (size_t)(t + 1) * kstep;
            const char* a2 = last ? nA : cA + (size_t)(t + 2) * kstep; const char* b2 = last ? nB : cB + (size_t)(t + 2) * kstep;
            const char* a3 = a2 + kstep; const char* b3 = b2 + kstep;
            PG8_LDB(B0, 0, 0); PG8_LDB(B1, 0, 1); PG8_SCHED; PG8_LDA(At, 0, 0); PG8_STAGE(PG8_SA(1, 1), a1 + hstepA, voffA);
            PG8_WAIT_V(8); PG8_WAIT_L(0); PG8_BAR; PG8_MMA(0, 0, At, B0); PG8_MMA(0, 1, At, B1); PG8_BAR; PG8_SCHED;
            PG8_LDA(At, 0, 1); PG8_STAGE(PG8_SB(0, 0), b2, voffB); PG8_STAGE(PG8_SB(0, 1), b2 + hstepB, voffB); PG8_STAGE(PG8_SA(0, 0), a2, voffA);
            PG8_WAIT_V(8); PG8_WAIT_L(0); PG8_BAR; PG8_MMA(1, 0, At, B0); PG8_MMA(1, 1, At, B1); PG8_BAR; PG8_SCHED;
            PG8_LDB(B0, 1, 0); PG8_LDB(B1, 1, 1); PG8_SCHED; PG8_LDA(At, 1, 0); PG8_STAGE(PG8_SA(0, 1), a2 + hstepA, voffA);
            PG8_WAIT_V(8); PG8_WAIT_L(0); PG8_BAR; PG8_MMA(0, 0, At, B0); PG8_MMA(0, 1, At, B1); PG8_BAR; PG8_SCHED;
            PG8_LDA(At, 1, 1); PG8_STAGE(PG8_SB(1, 0), b3, voffB); PG8_STAGE(PG8_SB(1, 1), b3 + hstepB, voffB); PG8_STAGE(PG8_SA(1, 0), a3, voffA);
            PG8_WAIT_V(8); PG8_WAIT_L(0); PG8_BAR; PG8_MMA(1, 0, At, B0); PG8_MMA(1, 1, At, B1); PG8_BAR; PG8_SCHED;
        }
        if (wr == 0) PG8_BAR;
        if (emode == 1) { EpiSwiGLU E{O, ldc}; E(acc, cur, wr, wc, fr, fq); }
        else if (emode == 2) { EpiNA E{O, O + (size_t)34816 * 1024, O + (size_t)34816 * 1024 + (size_t)128 * 4352 * 64}; E(acc, cur, wr, wc, fr, fq); }
        else { EpiStore E{O, ldc}; E(acc, cur, wr, wc, fr, fq); }
        if (!has_next) break;
#pragma unroll
        for (int a = 0; a < 2; ++a)
#pragma unroll
            for (int b = 0; b < 2; ++b)
#pragma unroll
                for (int m = 0; m < 4; ++m)
#pragma unroll
                    for (int n = 0; n < 2; ++n) acc[a][b][m][n] = (f32x4){0.f, 0.f, 0.f, 0.f};
        cur = nxt; cA = nA; cB = nB; ++ui;
        if (wr == 1) PG8_BAR;
    }
    PG8_WAIT_V(0);
    PG8_BAR;
#undef PG8_SA
#undef PG8_SB
#undef PG8_STAGE
#undef PG8_LDA
#undef PG8_LDB
#undef PG8_MMA
#undef PG8_WAIT_V
#undef PG8_WAIT_L
#undef PG8_BAR
#undef PG8_SCHED
}
}

namespace att {
#define SBAR() __builtin_amdgcn_sched_barrier(0)
__device__ __forceinline__ int crow(int r, int hi) { return (r & 3) + 8 * (r >> 2) + 4 * hi; }
constexpr int V_BUF = 16384, KOFF = 32768, WSOFF = 81920, TABOFF = 83968;
constexpr float THR = 8.f;
__device__ __forceinline__ int k_off(int row, int cb) { return row * 128 + (cb ^ ((row & 7) << 4)); }
__device__ __forceinline__ int v_st(int k, int c) { const int kk = (k & ~0xC) | ((k & 4) << 1) | ((k & 8) >> 1); return ((kk >> 3) * 4 + (c >> 5)) * 512 + ((kk & 7) * 32 + (c & 31)) * 2; }
__device__ __forceinline__ int v_rd_base(int lane) { return ((lane & 3) << 3) | (((lane >> 2) & 3) << 6) | (((lane >> 4) & 1) << 5) | (((lane >> 5) & 1) << 8); }
constexpr int v_rd_off(int d0, int ks, int half) { return d0 * 512 + ks * 4096 + half * 2048; }
template <int OFF> __device__ __forceinline__ s16x4 tr_read(int vb) {
    s16x4 r; asm volatile("ds_read_b64_tr_b16 %0, %1 offset:%2" : "=&v"(r) : "v"(vb), "i"(OFF) : "memory"); return r;
}
template <int D0> __device__ __forceinline__ void pv_one(f32x16& od, int vb, bf16x8 pa0, bf16x8 pa1, bf16x8 pa2, bf16x8 pa3) {
    const s16x4 l0 = tr_read<v_rd_off(D0, 0, 0)>(vb), h0 = tr_read<v_rd_off(D0, 0, 1)>(vb), l1 = tr_read<v_rd_off(D0, 1, 0)>(vb), h1 = tr_read<v_rd_off(D0, 1, 1)>(vb);
    const s16x4 l2 = tr_read<v_rd_off(D0, 2, 0)>(vb), h2 = tr_read<v_rd_off(D0, 2, 1)>(vb), l3 = tr_read<v_rd_off(D0, 3, 0)>(vb), h3 = tr_read<v_rd_off(D0, 3, 1)>(vb);
    asm volatile("s_waitcnt lgkmcnt(0)" ::: "memory"); SBAR();
#define PK(L, H) (bf16x8){L[0], L[1], L[2], L[3], H[0], H[1], H[2], H[3]}
    od = __builtin_amdgcn_mfma_f32_32x32x16_bf16(pa0, PK(l0, h0), od, 0, 0, 0);
    od = __builtin_amdgcn_mfma_f32_32x32x16_bf16(pa1, PK(l1, h1), od, 0, 0, 0);
    od = __builtin_amdgcn_mfma_f32_32x32x16_bf16(pa2, PK(l2, h2), od, 0, 0, 0);
    od = __builtin_amdgcn_mfma_f32_32x32x16_bf16(pa3, PK(l3, h3), od, 0, 0, 0);
#undef PK
}

template <int DKB, int DVB>
__device__ __forceinline__ void compute_tile(LAS const unsigned char* Kb, int vb, const bf16x8* qr, f32x16* o, float& m_reg, float& l_reg, LAS float* ws,
                                             const float C, int r32, int hi, bool local, LAS const float* tp, const float* madd0, const float* madd1) {
            f32x16 p0 = f32x16{}, p1 = f32x16{};
            {
#pragma unroll
              for (int d0 = 0; d0 < DKB; ++d0) { const int cb = ((d0 & 3) * 16 + hi * 8) * 2;
                const bf16x8 b0 = *(LAS const bf16x8*)(Kb + (d0 >> 2) * 8192 + k_off(r32, cb));
                const bf16x8 b1 = *(LAS const bf16x8*)(Kb + (d0 >> 2) * 8192 + k_off(32 + r32, cb));
                p0 = __builtin_amdgcn_mfma_f32_32x32x16_bf16(b0, qr[d0], p0, 0, 0, 0);
                p1 = __builtin_amdgcn_mfma_f32_32x32x16_bf16(b1, qr[d0], p1, 0, 0, 0); } }
                        if (local) {
#pragma unroll
                for (int r = 0; r < 16; ++r) { const int kk = (r & 3) + 8 * (r >> 2);
                    p0[r] = fmaf(p0[r], C, tp[kk]) + madd0[r]; p1[r] = fmaf(p1[r], C, tp[32 + kk]) + madd1[r]; }
            }
            float pmax = p0[0];
#pragma unroll
            for (int r = 1; r < 16; ++r) pmax = fmaxf(pmax, p0[r]);
#pragma unroll
            for (int r = 0; r < 16; ++r) pmax = fmaxf(pmax, p1[r]);
            if (!local) pmax *= C;
            { auto rr = __builtin_amdgcn_permlane32_swap(__float_as_uint(pmax), __float_as_uint(pmax), false, false);
              pmax = fmaxf(__uint_as_float(rr[0]), __uint_as_float(rr[1])); }
            float alpha = 1.f;
            if (!__all(pmax - m_reg <= THR)) { const float mn = fmaxf(m_reg, pmax); alpha = __builtin_amdgcn_exp2f(m_reg - mn); m_reg = mn; }
            if (local) {
#pragma unroll
                for (int r = 0; r < 16; ++r) { p0[r] = __builtin_amdgcn_exp2f(p0[r] - m_reg); p1[r] = __builtin_amdgcn_exp2f(p1[r] - m_reg); }
            } else {
                const float nm = -m_reg;
#pragma unroll
                for (int r = 0; r < 16; ++r) { p0[r] = __builtin_amdgcn_exp2f(fmaf(p0[r], C, nm)); p1[r] = __builtin_amdgcn_exp2f(fmaf(p1[r], C, nm)); }
            }
            float ps = 0.f;
#pragma unroll
            for (int r = 0; r < 16; ++r) ps += p0[r];
#pragma unroll
            for (int r = 0; r < 16; ++r) ps += p1[r];
            { auto rr = __builtin_amdgcn_permlane32_swap(__float_as_uint(ps), __float_as_uint(ps), false, false);
              ps = __uint_as_float(rr[0]) + __uint_as_float(rr[1]); }
            l_reg = l_reg * alpha + ps;
            bf16x8 pa0, pa1, pa2, pa3;
#define PK4(P, BASE, OUT) do { unsigned a0 = cvt_pk_bf16(P[BASE + 0], P[BASE + 1]), a1 = cvt_pk_bf16(P[BASE + 2], P[BASE + 3]);   \
    unsigned b0 = cvt_pk_bf16(P[BASE + 4], P[BASE + 5]), b1 = cvt_pk_bf16(P[BASE + 6], P[BASE + 7]);                              \
    auto r0_ = __builtin_amdgcn_permlane32_swap(a0, b0, false, false); auto r1_ = __builtin_amdgcn_permlane32_swap(a1, b1, false, false); \
    u32x4 w_ = {r0_[0], r1_[0], r0_[1], r1_[1]}; OUT = __builtin_bit_cast(bf16x8, w_); } while (0)
            PK4(p0, 0, pa0); PK4(p0, 8, pa1); PK4(p1, 0, pa2); PK4(p1, 8, pa3);
#undef PK4
            if (__any(alpha < 1.f)) { if (hi == 0) ws[r32] = alpha; asm volatile("s_waitcnt lgkmcnt(0)" ::: "memory");
#pragma unroll
                for (int d = 0; d < DVB; ++d)
#pragma unroll
                    for (int r = 0; r < 16; ++r) o[d][r] *= ws[crow(r, hi)]; }
            SBAR();
            pv_one<0>(o[0], vb, pa0, pa1, pa2, pa3); pv_one<1>(o[1], vb, pa0, pa1, pa2, pa3);
            if constexpr (DVB == 4) { pv_one<2>(o[2], vb, pa0, pa1, pa2, pa3); pv_one<3>(o[3], vb, pa0, pa1, pa2, pa3); }
}

struct AttnU {
    const bf16_t* Qw; int ldq;
    const bf16_t* K0; int ldk0;
    const bf16_t* K2; int ldk2;
    const bf16_t* V; int ldv;
    bf16_t* O; int ldo;
    int baseA, nA, baseB, NT;
    int rope_pos0;
    int lo, r0;
    const float* rpb_h;
};

template <int DKB, int DVB, int MODE>
__device__ __forceinline__ void attn_unit(LAS unsigned char* lds, const AttnU& u, const float C) {
    int tid = threadIdx.x; asm volatile("" : "+v"(tid));
    const int lane = tid & 63, r32 = lane & 31, hi = lane >> 5;
    const int wid = __builtin_amdgcn_readfirstlane(tid >> 6);
    constexpr int NKR = DKB / 4, KBUF = NKR * 8192;
    LAS float* ws = (LAS float*)(lds + WSOFF) + wid * 64;
    LAS float* tab = (LAS float*)(lds + TABOFF);
    if constexpr (MODE == 1) { for (int i_ = tid; i_ < 640; i_ += NTHREADS) { const int s_ = i_ - 64; tab[i_] = (s_ >= 0 && s_ < 465) ? u.rpb_h[s_] * LOG2E : 0.f; } }
    bf16x8 qr[DKB];
    { const bf16_t* q = u.Qw + (size_t)(wid * 32 + r32) * u.ldq + hi * 8;
#pragma unroll
      for (int d0 = 0; d0 < DKB; ++d0) qr[d0] = *(const bf16x8*)(q + d0 * 16); }
    if constexpr (MODE == 0) {
        if (u.rope_pos0 >= 0) {
            const int t = u.rope_pos0 + wid * 32 + r32; const float grow = (float)(t >> 6), gcol = (float)(t & 63);
#pragma unroll
            for (int dd = 0; dd < 2; ++dd) {
                const float pos = dd == 0 ? grow : gcol;
#pragma unroll
                for (int j = 0; j < 8; ++j) {
                    const float inv = __builtin_amdgcn_exp2f(-(float)(8 * hi + j) * 0.8304820237218406f);
                    const float ang = pos * inv; const float cs = __cosf(ang), sn = __sinf(ang);
                    const float x1 = bf2f((unsigned short)qr[8 + dd][j]), x2 = bf2f((unsigned short)qr[10 + dd][j]);
                    const float o1 = x1 * cs - x2 * sn, o2 = x1 * sn + x2 * cs;
                    const unsigned w = cvt_pk_bf16(o1, o2);
                    qr[8 + dd][j] = (short)(w & 0xffffu); qr[10 + dd][j] = (short)(w >> 16);
                }
            }
        }
    }
    const int krow = tid >> 3, kc = tid & 7;
    const int kdst = k_off(krow, kc * 16);
    const int sr = tid >> 4, sc = (tid & 15) * 8;
    const int vdst0 = (MODE == 0) ? v_st(sr, sc) : v_st(krow, kc * 8);
    const int vdst1 = v_st(32 + sr, sc);
    bf16x8 ks[NKR], vs[DVB / 2];
#define TILE_ROW(t) (((t) < u.nA) ? (u.baseA + 64 * (t)) : (u.baseB + 64 * ((t) - u.nA)))
#define SLOAD(rb, KS, VS) do { const size_t kr_ = (size_t)((rb) + krow); \
        if constexpr (MODE == 0) { KS[0] = *(const bf16x8*)(u.K0 + kr_ * u.ldk0 + kc * 8); KS[1] = *(const bf16x8*)(u.K0 + kr_ * u.ldk0 + 64 + kc * 8); KS[2] = *(const bf16x8*)(u.K2 + kr_ * u.ldk2 + kc * 8); \
            VS[0] = *(const bf16x8*)(u.V + (size_t)((rb) + sr) * u.ldv + sc); VS[1] = *(const bf16x8*)(u.V + (size_t)((rb) + 32 + sr) * u.ldv + sc); } \
        else { KS[0] = *(const bf16x8*)(u.K0 + kr_ * u.ldk0 + kc * 8); VS[0] = *(const bf16x8*)(u.V + kr_ * u.ldv + kc * 8); } } while (0)
#define SWRITE(KO, KB, b, KS, VS) do { _Pragma("unroll") for (int g_ = 0; g_ < NKR; ++g_) *(LAS bf16x8*)(lds + (KO) + (b) * (KB) + g_ * 8192 + kdst) = KS[g_]; \
        *(LAS bf16x8*)(lds + (b) * V_BUF + vdst0) = VS[0]; if constexpr (MODE == 0) *(LAS bf16x8*)(lds + (b) * V_BUF + vdst1) = VS[1]; } while (0)
    const int vb0 = (int)(unsigned)(uintptr_t)(lds) + v_rd_base(lane);
    float m_reg = -1e30f, l_reg = 0.f;
    f32x16 o[DVB];
#pragma unroll
    for (int d = 0; d < DVB; ++d) o[d] = f32x16{};
    const int qc = 32 * (wid & 1) + r32; const int cs0 = min(max(qc - 8, 0), 48);
    const int rq = u.r0 + (wid >> 1); const int rs = min(max(rq - 4, 0), 56);
    float madd0[16], madd1[16];
    if constexpr (MODE == 1) {
#pragma unroll
        for (int r = 0; r < 16; ++r) { const int kc0 = crow(r, hi), kc1 = kc0 + 32;
            madd0[r] = ((kc0 >= cs0) && (kc0 < cs0 + 16)) ? 0.f : -__builtin_inff(); madd1[r] = ((kc1 >= cs0) && (kc1 < cs0 + 16)) ? 0.f : -__builtin_inff(); }
    }
    const int NT = u.NT;
    if constexpr (MODE == 0) {
        { const int rb0 = TILE_ROW(0); SLOAD(rb0, ks, vs); SWRITE(KOFF, KBUF, 0, ks, vs); }
        __syncthreads();
        for (int j = 0; j < NT; ++j) {
            const int buf = j & 1;
            if (j + 1 < NT) { const int rbn = TILE_ROW(j + 1); SLOAD(rbn, ks, vs); }
            compute_tile<DKB, DVB>(lds + KOFF + buf * KBUF, vb0 + buf * V_BUF, qr, o, m_reg, l_reg, ws, C, r32, hi, false, tab, madd0, madd1);
            if (j + 1 < NT) { SWRITE(KOFF, KBUF, buf ^ 1, ks, vs); }
            __syncthreads();
        }
    } else {
        constexpr int KOFF1 = 3 * V_BUF;
        bf16x8 ks2[NKR], vs2[DVB / 2];
        { const int rb0 = TILE_ROW(0); SLOAD(rb0, ks, vs); SWRITE(KOFF1, KBUF, 0, ks, vs); }
        if (NT > 1) { const int rb1 = TILE_ROW(1); SLOAD(rb1, ks2, vs2); }
        __syncthreads();
        int st = 0;
#define NA_STEP(j_, LS_K, LS_V, WS_K, WS_V) do { const int jj = (j_); \
            if (jj + 2 < NT) { const int rbn = TILE_ROW(jj + 2); SLOAD(rbn, LS_K, LS_V); } \
            bool active = true; int rho = 0; const bool local = jj < u.nA; \
            if (local) { rho = u.lo + jj; active = (rho >= rs) && (rho < rs + 8); } \
            if (active) compute_tile<DKB, DVB>(lds + KOFF1 + st * KBUF, vb0 + st * V_BUF, qr, o, m_reg, l_reg, ws, C, r32, hi, local, tab + 64 + ((rho - rq + 7) * 31 - qc + 15 + 4 * hi), madd0, madd1); \
            const int stn = (st == 2) ? 0 : st + 1; \
            if (jj + 1 < NT) { SWRITE(KOFF1, KBUF, stn, WS_K, WS_V); } \
            st = stn; __syncthreads(); } while (0)
        for (int j = 0; j < NT; j += 2) {
            NA_STEP(j, ks, vs, ks2, vs2);
            if (j + 1 < NT) NA_STEP(j + 1, ks2, vs2, ks, vs);
        }
#undef NA_STEP
    }
    if (hi == 0) ws[r32] = l_reg; asm volatile("s_waitcnt lgkmcnt(0)" ::: "memory");
    float rli[16];
#pragma unroll
    for (int r = 0; r < 16; ++r) rli[r] = fast_rcp(ws[crow(r, hi)]);
    bf16_t* Ow = u.O + (size_t)(wid * 32) * u.ldo;
#pragma unroll
    for (int r = 0; r < 16; ++r) { const int orow = crow(r, hi);
#pragma unroll
        for (int d0 = 0; d0 < DVB; ++d0) { const unsigned w = cvt_pk_bf16(o[d0][r] * rli[r], 0.f); Ow[(size_t)orow * u.ldo + d0 * 32 + r32] = (bf16_t)(w & 0xffffu); } }
    asm volatile("s_waitcnt lgkmcnt(0)" ::: "memory");
    __syncthreads();
#undef TILE_ROW
#undef SLOAD
#undef SWRITE
}
__device__ __forceinline__ int v_st2(int k, int c) { const int kk = (k & ~0xC) | ((k & 4) << 1) | ((k & 8) >> 1); return ((kk >> 3) * 2 + (c >> 5)) * 512 + ((kk & 7) * 32 + (c & 31)) * 2; }
constexpr int v_rd_off2(int d0, int ks, int half) { return d0 * 512 + ks * 2048 + half * 1024; }
template <int D0, int NK> __device__ __forceinline__ void pv_blk2(f32x16& od, int vb, bf16x8 pa0, bf16x8 pa1, bf16x8 pa2, bf16x8 pa3) {
    const s16x4 l0 = tr_read<v_rd_off2(D0, 0, 0)>(vb), h0 = tr_read<v_rd_off2(D0, 0, 1)>(vb), l1 = tr_read<v_rd_off2(D0, 1, 0)>(vb), h1 = tr_read<v_rd_off2(D0, 1, 1)>(vb);
    s16x4 l2 = l0, h2 = h0, l3 = l1, h3 = h1;
    if constexpr (NK == 4) { l2 = tr_read<v_rd_off2(D0, 2, 0)>(vb); h2 = tr_read<v_rd_off2(D0, 2, 1)>(vb); l3 = tr_read<v_rd_off2(D0, 3, 0)>(vb); h3 = tr_read<v_rd_off2(D0, 3, 1)>(vb); }
    asm volatile("s_waitcnt lgkmcnt(0)" ::: "memory"); SBAR();
#define PK(L, H) (bf16x8){L[0], L[1], L[2], L[3], H[0], H[1], H[2], H[3]}
    od = __builtin_amdgcn_mfma_f32_32x32x16_bf16(pa0, PK(l0, h0), od, 0, 0, 0);
    od = __builtin_amdgcn_mfma_f32_32x32x16_bf16(pa1, PK(l1, h1), od, 0, 0, 0);
    if constexpr (NK == 4) { od = __builtin_amdgcn_mfma_f32_32x32x16_bf16(pa2, PK(l2, h2), od, 0, 0, 0); od = __builtin_amdgcn_mfma_f32_32x32x16_bf16(pa3, PK(l3, h3), od, 0, 0, 0); }
#undef PK
}
#define NA2_PK4(P, BASE, OUT) do { unsigned a0_ = cvt_pk_bf16(P[BASE + 0], P[BASE + 1]), a1_ = cvt_pk_bf16(P[BASE + 2], P[BASE + 3]);   \
    unsigned b0_ = cvt_pk_bf16(P[BASE + 4], P[BASE + 5]), b1_ = cvt_pk_bf16(P[BASE + 6], P[BASE + 7]);                              \
    auto r0_ = __builtin_amdgcn_permlane32_swap(a0_, b0_, false, false); auto r1_ = __builtin_amdgcn_permlane32_swap(a1_, b1_, false, false); \
    u32x4 w_ = {r0_[0], r1_[0], r0_[1], r1_[1]}; OUT = __builtin_bit_cast(bf16x8, w_); } while (0)
__device__ __forceinline__ void attn_unit_na2(LAS unsigned char* lds, const AttnU& u, const float C) {
    int tid = threadIdx.x; asm volatile("" : "+v"(tid));
    const int lane = tid & 63, r32 = lane & 31, hi = lane >> 5;
    const int wid = __builtin_amdgcn_readfirstlane(tid >> 6);
    constexpr int TSZ = 24576, STG = 2 * TSZ, VOFFA = 8192, VOFFB = 16384, WS2 = 98304, TAB2 = 100352;
    LAS float* ws = (LAS float*)(lds + WS2) + wid * 64;
    LAS float* tab = (LAS float*)(lds + TAB2);
    for (int i_ = tid; i_ < 640; i_ += NTHREADS) { const int s_ = i_ - 64; tab[i_] = (s_ >= 0 && s_ < 465) ? u.rpb_h[s_] * LOG2E : 0.f; }
    const int pr = wid >> 2, g = wid & 3;
    const int ra = u.r0 + 2 * pr;
    const int sg = g == 0 ? 0 : (g == 1 ? 8 : (g == 2 ? 24 : 32));
    const int rl = ra + (r32 >> 4), qc = 16 * g + (r32 & 15);
    const int cs0 = min(max(qc - 8, 0), 48), rsl = min(max(rl - 4, 0), 56);
    const int rsA = min(max(ra - 4, 0), 56), rsB = min(max(ra + 1 - 4, 0), 56);
    bf16x8 qr[4];
    { const bf16_t* q = u.Qw + (size_t)((2 * pr + (r32 >> 4)) * 64 + 16 * g + (r32 & 15)) * u.ldq + hi * 8;
#pragma unroll
      for (int d0 = 0; d0 < 4; ++d0) qr[d0] = *(const bf16x8*)(q + d0 * 16); }
    const int krow = tid >> 3, kc = tid & 7;
    const int kdst = k_off(krow, kc * 16), vdstA = v_st2(krow, kc * 8), vdstB = v_st2((krow + 56) & 63, kc * 8);
    const int ldsb = (int)(unsigned)(uintptr_t)(lds);
    const int vbl = ldsb + ((g == 1 || g == 2) ? VOFFB : VOFFA) + ((g == 2) ? 2048 : (g == 3 ? 4096 : 0)) + v_rd_base(lane);
    const int vbc = ldsb + VOFFA + v_rd_base(lane);
    const int tq = sg + 4 * hi - cs0;
    float m_reg = -1e30f, l_reg = 0.f;
    f32x16 o[2]; o[0] = f32x16{}; o[1] = f32x16{};
    const int NT = u.NT;
#define TILE_ROW(t) (((t) < u.nA) ? (u.baseA + 64 * (t)) : (u.baseB + 64 * ((t) - u.nA)))
#define SLOAD1(t_, KS, VS) do { const size_t kr_ = (size_t)(TILE_ROW(t_) + krow); KS = *(const bf16x8*)(u.K0 + kr_ * u.ldk0 + kc * 8); VS = *(const bf16x8*)(u.V + kr_ * u.ldv + kc * 8); } while (0)
#define SWRITE1(sb_, KS, VS) do { *(LAS bf16x8*)((sb_) + kdst) = KS; *(LAS bf16x8*)((sb_) + VOFFA + vdstA) = VS; *(LAS bf16x8*)((sb_) + VOFFB + vdstB) = VS; } while (0)
    bf16x8 k0 = bf16x8{}, v0 = bf16x8{}, k1 = bf16x8{}, v1 = bf16x8{};
    const int NP = (NT + 1) >> 1;
    SLOAD1(0, k0, v0); if (NT > 1) SLOAD1(1, k1, v1);
    SWRITE1(lds, k0, v0); SWRITE1(lds + TSZ, k1, v1);
    __syncthreads();
    int toff = 0;
    auto na2_tile = [&](int jj) __attribute__((always_inline)) {
        LAS const unsigned char* sb = lds + toff;
        const bool local = jj < u.nA;
        f32x16 p0, p1; float alpha = 1.f; bf16x8 pa0, pa1, pa2 = bf16x8{}, pa3 = bf16x8{};
        if (local) {
            const int rho = u.lo + jj;
            if (!((rho >= rsA) && (rho < rsB + 8))) return;
            p0 = f32x16{};
#pragma unroll
            for (int d0 = 0; d0 < 4; ++d0) { const int cb = (d0 * 16 + hi * 8) * 2;
                const bf16x8 b0 = *(LAS const bf16x8*)(sb + k_off(sg + r32, cb));
                p0 = __builtin_amdgcn_mfma_f32_32x32x16_bf16(b0, qr[d0], p0, 0, 0, 0); }
            const bool rowok = (rho >= rsl) && (rho < rsl + 8);
            const int drc = min(max(rho - rl + 7, 0), 14);
            LAS const float* tp = tab + 64 + (drc * 31 - qc + 15 + sg + 4 * hi);
#pragma unroll
            for (int r = 0; r < 16; ++r) { const int kk = (r & 3) + 8 * (r >> 2);
                p0[r] = (rowok && ((unsigned)(kk + tq) < 16u)) ? fmaf(p0[r], C, tp[kk]) : -__builtin_inff(); }
            float pmax = p0[0];
#pragma unroll
            for (int r = 1; r < 16; ++r) pmax = fmaxf(pmax, p0[r]);
            { auto rr = __builtin_amdgcn_permlane32_swap(__float_as_uint(pmax), __float_as_uint(pmax), false, false);
              pmax = fmaxf(__uint_as_float(rr[0]), __uint_as_float(rr[1])); }
            if (!__all(pmax - m_reg <= THR)) { const float mn = fmaxf(m_reg, pmax); alpha = __builtin_amdgcn_exp2f(m_reg - mn); m_reg = mn; }
            float ps = 0.f;
#pragma unroll
            for (int r = 0; r < 16; ++r) { p0[r] = __builtin_amdgcn_exp2f(p0[r] - m_reg); ps += p0[r]; }
            { auto rr = __builtin_amdgcn_permlane32_swap(__float_as_uint(ps), __float_as_uint(ps), false, false);
              ps = __uint_as_float(rr[0]) + __uint_as_float(rr[1]); }
            l_reg = l_reg * alpha + ps;
            NA2_PK4(p0, 0, pa0); NA2_PK4(p0, 8, pa1);
        } else {
            p0 = f32x16{}; p1 = f32x16{};
#pragma unroll
            for (int d0 = 0; d0 < 4; ++d0) { const int cb = (d0 * 16 + hi * 8) * 2;
                const bf16x8 b0 = *(LAS const bf16x8*)(sb + k_off(r32, cb));
                const bf16x8 b1 = *(LAS const bf16x8*)(sb + k_off(32 + r32, cb));
                p0 = __builtin_amdgcn_mfma_f32_32x32x16_bf16(b0, qr[d0], p0, 0, 0, 0);
                p1 = __builtin_amdgcn_mfma_f32_32x32x16_bf16(b1, qr[d0], p1, 0, 0, 0); }
            float pmax = p0[0];
#pragma unroll
            for (int r = 1; r < 16; ++r) pmax = fmaxf(pmax, p0[r]);
#pragma unroll
            for (int r = 0; r < 16; ++r) pmax = fmaxf(pmax, p1[r]);
            pmax *= C;
            { auto rr = __builtin_amdgcn_permlane32_swap(__float_as_uint(pmax), __float_as_uint(pmax), false, false);
              pmax = fmaxf(__uint_as_float(rr[0]), __uint_as_float(rr[1])); }
            if (!__all(pmax - m_reg <= THR)) { const float mn = fmaxf(m_reg, pmax); alpha = __builtin_amdgcn_exp2f(m_reg - mn); m_reg = mn; }
            const float nm = -m_reg; float ps = 0.f;
#pragma unroll
            for (int r = 0; r < 16; ++r) { p0[r] = __builtin_amdgcn_exp2f(fmaf(p0[r], C, nm)); p1[r] = __builtin_amdgcn_exp2f(fmaf(p1[r], C, nm)); ps += p0[r] + p1[r]; }
            { auto rr = __builtin_amdgcn_permlane32_swap(__float_as_uint(ps), __float_as_uint(ps), false, false);
              ps = __uint_as_float(rr[0]) + __uint_as_float(rr[1]); }
            l_reg = l_reg * alpha + ps;
            NA2_PK4(p0, 0, pa0); NA2_PK4(p0, 8, pa1); NA2_PK4(p1, 0, pa2); NA2_PK4(p1, 8, pa3);
        }
        if (__any(alpha < 1.f)) { if (hi == 0) ws[r32] = alpha; asm volatile("s_waitcnt lgkmcnt(0)" ::: "memory");
#pragma unroll
            for (int d = 0; d < 2; ++d)
#pragma unroll
                for (int r = 0; r < 16; ++r) o[d][r] *= ws[crow(r, hi)]; }
        SBAR();
        if (local) { const int vb = vbl + toff; pv_blk2<0, 2>(o[0], vb, pa0, pa1, pa2, pa3); pv_blk2<1, 2>(o[1], vb, pa0, pa1, pa2, pa3); }
        else { const int vb = vbc + toff; pv_blk2<0, 4>(o[0], vb, pa0, pa1, pa2, pa3); pv_blk2<1, 4>(o[1], vb, pa0, pa1, pa2, pa3); }
    };
    for (int p = 0; p < NP; ++p) {
        const int sbase = (p & 1) * STG;
        if (p + 1 < NP) { SLOAD1(2 * p + 2, k0, v0); if (2 * p + 3 < NT) SLOAD1(2 * p + 3, k1, v1); }
        toff = sbase; na2_tile(2 * p);
        if (2 * p + 1 < NT) { toff = sbase + TSZ; na2_tile(2 * p + 1); }
        if (p + 1 < NP) { LAS unsigned char* nb = lds + (STG - sbase); SWRITE1(nb, k0, v0); SWRITE1(nb + TSZ, k1, v1); }
        __syncthreads();
    }
#undef SLOAD1
#undef SWRITE1
#undef TILE_ROW
    if (hi == 0) ws[r32] = l_reg; asm volatile("s_waitcnt lgkmcnt(0)" ::: "memory");
    float rli[16];
#pragma unroll
    for (int r = 0; r < 16; ++r) rli[r] = fast_rcp(ws[crow(r, hi)]);
#pragma unroll
    for (int r = 0; r < 16; ++r) { const int q = crow(r, hi); bf16_t* orow = u.O + (size_t)((2 * pr + (q >> 4)) * 64 + 16 * g + (q & 15)) * u.ldo;
#pragma unroll
        for (int d0 = 0; d0 < 2; ++d0) { const unsigned w = cvt_pk_bf16(o[d0][r] * rli[r], 0.f); orow[d0 * 32 + r32] = (bf16_t)(w & 0xffffu); } }
    asm volatile("s_waitcnt lgkmcnt(0)" ::: "memory");
    __syncthreads();
}
#undef NA2_PK4
#undef SBAR
}

#define XB_TMO      128
#define XB_XCNT(j)  (256  + 64 * (j))
#define XB_XSUB(j)  (1280 + 64 * (j))
#define XB_XGEN(j)  (2304 + 64 * (j))
#define XB_TOP      3328
#define XB_TOPGEN   3392
#define XCD_BAR_WORDS 3456
#define XB_SPIN_CAP (1u << 22)
__device__ __forceinline__ unsigned xb_ld(unsigned* p)              { return __hip_atomic_load(p, __ATOMIC_RELAXED, __HIP_MEMORY_SCOPE_AGENT); }
__device__ __forceinline__ unsigned xb_add(unsigned* p, unsigned v) { return __hip_atomic_fetch_add(p, v, __ATOMIC_RELAXED, __HIP_MEMORY_SCOPE_AGENT); }
__device__ __forceinline__ unsigned xb_xcc_id() { return (unsigned)__builtin_amdgcn_s_getreg((3 << 11) | 20) & 0xFu; }
#define XB_SPIN(cond, bar) do { unsigned _sp = 0; while (cond) { __builtin_amdgcn_s_sleep(1); \
    if ((++_sp & 255u) == 0u) { if (xb_ld(&(bar)[XB_TMO])) break; if (_sp > XB_SPIN_CAP) { atomicAdd(&(bar)[XB_TMO], 1u); break; } } } } while (0)
struct XcdBarrier { unsigned* bar; unsigned x; volatile LAS unsigned* st; };
__device__ __forceinline__ XcdBarrier xcd_barrier_post(unsigned* bar, volatile LAS unsigned* st) {
    XcdBarrier b; b.bar = bar; b.x = xb_xcc_id(); b.st = st;
    if (threadIdx.x == 0) (void)xb_add(&bar[XB_XCNT(b.x)], 1u);
    return b;
}
__device__ __forceinline__ void xcd_barrier_complete(unsigned* bar, unsigned x, unsigned& nloc, unsigned& nx) {
    const unsigned G = gridDim.x * gridDim.y * gridDim.z;
    unsigned sum, cnt, mine, sp = 0u;
    for (;;) {
        sum = 0u; cnt = 0u; mine = 0u;
#pragma unroll
        for (unsigned j = 0; j < 16; ++j) { const unsigned c = xb_ld(&bar[XB_XCNT(j)]); sum += c; cnt += (c > 0u) ? 1u : 0u; mine = (j == x) ? c : mine; }
        if (sum == G) break;
        __builtin_amdgcn_s_sleep(1);
        if ((++sp & 255u) == 0u) { if (xb_ld(&bar[XB_TMO])) break; if (sp > XB_SPIN_CAP) { atomicAdd(&bar[XB_TMO], 1u); break; } }
    }
    nloc = mine > 0u ? mine : 1u; nx = cnt > 0u ? cnt : 1u;
}
__device__ __forceinline__ void xcd_barrier(const XcdBarrier& b) {
    asm volatile("s_waitcnt vmcnt(0)" ::: "memory");
    __syncthreads();
    if (threadIdx.x == 0) {
        unsigned* bar = b.bar;
        __builtin_amdgcn_s_waitcnt(0);
        unsigned nloc = b.st[0], nx = b.st[1];
        if (nloc == 0u) { xcd_barrier_complete(bar, b.x, nloc, nx); b.st[0] = nloc; b.st[1] = nx; }
        const unsigned old = xb_add(&bar[XB_XSUB(b.x)], 1u);
        const unsigned gen = old / nloc;
        if (old + 1u == (gen + 1u) * nloc) {
            __builtin_amdgcn_fence(__ATOMIC_RELEASE, "agent");
            asm volatile("s_waitcnt vmcnt(0)" ::: "memory");
            const unsigned og = xb_add(&bar[XB_TOP], 1u);
            const unsigned tg = og / nx;
            if (og + 1u == (tg + 1u) * nx) xb_add(&bar[XB_TOPGEN], 1u);
            else XB_SPIN(xb_ld(&bar[XB_TOPGEN]) == tg, bar);
            __builtin_amdgcn_fence(__ATOMIC_ACQUIRE, "agent");
            xb_add(&bar[XB_XGEN(b.x)], 1u);
            asm volatile("s_waitcnt vmcnt(0)" ::: "memory");
        } else {
            XB_SPIN(xb_ld(&bar[XB_XGEN(b.x)]) == gen, bar);
            __builtin_amdgcn_fence(__ATOMIC_ACQUIRE, "agent");
            asm volatile("s_waitcnt vmcnt(0)" ::: "memory");
        }
    }
    __syncthreads();
}

struct Params { const float* in[20]; float* out; unsigned char* ws; };
template <class T> __device__ __forceinline__ T* uni_ptr(T* p) {
    unsigned long long v = (unsigned long long)p; unsigned lo = __builtin_amdgcn_readfirstlane((unsigned)v), hi = __builtin_amdgcn_readfirstlane((unsigned)(v >> 32));
    typedef __attribute__((address_space(1))) T* gptr_t;
    return (T*)(gptr_t)(((unsigned long long)hi << 32) | lo); }
struct ParamsView {
    const Params* k;
    struct InView { const Params* k; __device__ __forceinline__ const float* operator[](int i) const { return uni_ptr(k->in[i]); } } in;
    float* out; unsigned char* ws;
};
__device__ __forceinline__ ParamsView kargs() { const void* k = (const void*)__builtin_amdgcn_kernarg_segment_ptr(); asm volatile("" : "+s"(k));
    ParamsView v; v.k = (const Params*)k; v.in.k = v.k; v.out = uni_ptr(v.k->out); v.ws = uni_ptr(v.k->ws); return v; }

__device__ __forceinline__ void transpose_item(const float* W, int K, int N, bf16_t* WT, int row_off, const float* scale, bool gu, int item, int lane) {
    const int nblk = N / 64, kb = item / nblk, nb = item % nblk, k0 = 64 * kb, n0 = 64 * nb;
    const int kg = lane >> 4, nq = lane & 15;
    const float* src = W + (size_t)(k0 + 16 * kg) * N + n0 + 4 * nq;
    f32x4 v[16];
#pragma unroll
    for (int i = 0; i < 16; ++i) v[i] = __builtin_nontemporal_load((const f32x4*)(src + (size_t)i * N));
    f32x4 sc4 = (f32x4){1.f, 1.f, 1.f, 1.f};
    if (scale) sc4 = *(const f32x4*)(scale + n0 + 4 * nq);
#pragma unroll
    for (int e = 0; e < 4; ++e) {
        int drow = n0 + 4 * nq + e; if (gu) { const int jj = drow < FFH ? drow : drow - FFH; drow = (jj >> 7) * 256 + (jj & 127) + (drow < FFH ? 0 : 128); }
        bf16_t* dst = WT + (size_t)(row_off + drow) * K + k0 + 16 * kg; const float sc = sc4[e];
#pragma unroll
        for (int h = 0; h < 2; ++h) { u32x4 o;
            o.x = cvt_pk_bf16(v[8 * h + 0][e] * sc, v[8 * h + 1][e] * sc); o.y = cvt_pk_bf16(v[8 * h + 2][e] * sc, v[8 * h + 3][e] * sc);
            o.z = cvt_pk_bf16(v[8 * h + 4][e] * sc, v[8 * h + 5][e] * sc); o.w = cvt_pk_bf16(v[8 * h + 6][e] * sc, v[8 * h + 7][e] * sc);
            *(u32x4*)(dst + 8 * h) = o; }
    }
}

__device__ __forceinline__ void phase_p0(LAS unsigned char* lds) {
    const ParamsView p = kargs();
    int tid = threadIdx.x; asm volatile("" : "+v"(tid));
    const int lane = tid & 63, wave = __builtin_amdgcn_readfirstlane(tid >> 6);
    unsigned char* ws = p.ws;
    {
        LAS float* S = (LAS float*)lds;
        LAS float* R = (LAS float*)(lds + 49152);
        for (int idx = tid; idx < 9 * 1024; idx += NTHREADS) { const int cnd = idx >> 10, k = idx & 1023;
            const float v = cnd < 8 ? p.in[1][cnd * 1024 + k] : p.in[3][k]; S[k * 12 + cnd] = silu_f(v); }
        __syncthreads();
        float* MOD = (float*)(ws + WS_MOD);
        for (int item = blockIdx.x; item < 4 * 192; item += gridDim.x) {
            const int layer = item / 192, cb = item % 192; const int col0 = cb * 32 + (lane & 7) * 4;
            const int kbase = wave * 128 + (lane >> 3) * 16;
            const float* W = p.in[4] + (size_t)layer * 1024 * 6144 + col0;
            f32x4 acc[9];
#pragma unroll
            for (int c = 0; c < 9; ++c) acc[c] = (f32x4){0.f, 0.f, 0.f, 0.f};
            f32x4 wv[16];
#pragma unroll
            for (int kk = 0; kk < 16; ++kk) wv[kk] = __builtin_nontemporal_load((const f32x4*)(W + (size_t)(kbase + kk) * 6144));
#pragma unroll
            for (int kk = 0; kk < 16; ++kk) { const int k = kbase + kk; const f32x4 w = wv[kk];
                const f32x4 s0 = *(LAS const f32x4*)(S + k * 12), s1 = *(LAS const f32x4*)(S + k * 12 + 4); const float s8 = S[k * 12 + 8];
                acc[0] += w * s0[0]; acc[1] += w * s0[1]; acc[2] += w * s0[2]; acc[3] += w * s0[3];
                acc[4] += w * s1[0]; acc[5] += w * s1[1]; acc[6] += w * s1[2]; acc[7] += w * s1[3]; acc[8] += w * s8; }
#pragma unroll
            for (int c = 0; c < 9; ++c)
#pragma unroll
                for (int e = 0; e < 4; ++e) { float v = acc[c][e]; v += __shfl_xor(v, 8); v += __shfl_xor(v, 16); v += __shfl_xor(v, 32); acc[c][e] = v; }
            if (lane < 8) {
#pragma unroll
                for (int c = 0; c < 9; ++c) *(LAS f32x4*)(R + (wave * 9 + c) * 32 + lane * 4) = acc[c]; }
            __syncthreads();
            for (int o = tid; o < 288; o += NTHREADS) { const int c = o >> 5, col = o & 31; float s = 0.f;
#pragma unroll
                for (int w = 0; w < 8; ++w) s += R[(w * 9 + c) * 32 + col];
                MOD[(size_t)(layer * 9 + c) * 6144 + cb * 32 + col] = s + p.in[5][layer * 6144 + cb * 32 + col]; }
            __syncthreads();
        }
    }
    __syncthreads();
    LAS float* scr = (LAS float*)(lds + wave * 16384);
    const int gw = blockIdx.x * NWAVES + wave, NGW = gridDim.x * NWAVES;
    {
        constexpr int I_GU = 16 * 88, I_DN = 44 * 16, I_PL = 4 * 4, I_MIN = 16 * 11, I_QB = 6 * 24, I_KVB = 4 * 32, I_MO = 16 * 16, I_NIN = 16 * 48, I_NO = 16 * 16;
        constexpr int E0 = 4 * I_GU, E1 = E0 + 4 * I_DN, E2 = E1 + 8 * I_PL, E3 = E2 + I_MIN, E4 = E3 + I_QB, E5 = E4 + I_KVB, E6 = E5 + I_MO, E7 = E6 + I_NIN, E8 = E7 + I_NO;
        for (int it = gw; it < E8; it += NGW) {
            const float* W; int K, N, row_off = 0, li; bf16_t* WT; const float* scale = nullptr; bool gu = false;
            if (it < E0) { const int l = it / I_GU; li = it - l * I_GU; W = p.in[7] + (size_t)l * DM * 2 * FFH; K = DM; N = 2 * FFH; WT = (bf16_t*)(ws + W_GU + l * SZ_GU); gu = true; }
            else if (it < E1) { const int r = it - E0, l = r / I_DN; li = r - l * I_DN; W = p.in[8] + (size_t)l * FFH * DM; K = FFH; N = DM; WT = (bf16_t*)(ws + W_DN + l * SZ_DN); }
            else if (it < E2) { const int r = it - E1, m = r / I_PL; li = r - m * I_PL; const int j = m >> 2, g = m & 3; W = p.in[9] + (size_t)m * 65536; K = 256; N = 256; WT = (bf16_t*)(ws + W_POOL + j * SZ_POOL); row_off = g * 256; scale = p.in[10] + j * 1024 + g * 256; }
            else if (it < E3) { li = it - E2; W = p.in[11]; K = 1024; N = 704; WT = (bf16_t*)(ws + W_MIN); }
            else if (it < E4) { li = it - E3; W = p.in[14]; K = 384; N = 1536; WT = (bf16_t*)(ws + W_QB); }
            else if (it < E5) { li = it - E4; W = p.in[15]; K = 256; N = 2048; WT = (bf16_t*)(ws + W_KVB); }
            else if (it < E6) { li = it - E5; W = p.in[16]; K = 1024; N = 1024; WT = (bf16_t*)(ws + W_MO); }
            else if (it < E7) { li = it - E6; W = p.in[17]; K = 1024; N = 3072; WT = (bf16_t*)(ws + W_NIN); }
            else { li = it - E7; W = p.in[19]; K = 1024; N = 1024; WT = (bf16_t*)(ws + W_NO); }
            transpose_item(W, K, N, WT, row_off, scale, gu, li, lane);
        }
    }
    { u32x4* z = (u32x4*)(ws + W_MIN + (size_t)704 * 1024 * 2); const int n16 = 64 * 1024 * 2 / 16;
      for (int i = blockIdx.x * NTHREADS + tid; i < n16; i += gridDim.x * NTHREADS) z[i] = (u32x4){0u, 0u, 0u, 0u}; }
}

struct EArgs {
    const float* xf_lat; const float* xf_ctx;
    const bf16_t* XBin;
    bf16_t* XBout; float* outf;
    const bf16_t* Y; const float* gy; const float* modg; int goff;
    bf16_t* H; const float* gh; const float* modh; int shoff, scoff;
    int M;
    const bf16_t* YP;
};
__device__ __forceinline__ void phase_enorm(const EArgs& a) {
    int tid_ = threadIdx.x; asm volatile("" : "+v"(tid_));
    const int lane = tid_ & 63, wave = __builtin_amdgcn_readfirstlane(tid_ >> 6);
    const int gw = blockIdx.x * NWAVES + wave, NGW = gridDim.x * NWAVES;
    const bool hasY = a.Y != nullptr, hasH = a.H != nullptr, srcf = a.xf_lat != nullptr;
    constexpr int RP = 2;
    const int c0 = 8 * lane;
    f32x4 xn[RP][4]; u32x4 xbn[RP][2], yn[RP][2];
#define E_LOAD(s_, r_) do { const int r__ = (r_); \
        if (srcf) { const float* xin_ = (r__ < M_LAT) ? a.xf_lat + (size_t)r__ * DM : a.xf_ctx + (size_t)(r__ - M_LAT) * DM; \
            _Pragma("unroll") for (int j = 0; j < 2; ++j) { xn[s_][2 * j] = __builtin_nontemporal_load((const f32x4*)(xin_ + c0 + 512 * j)); xn[s_][2 * j + 1] = __builtin_nontemporal_load((const f32x4*)(xin_ + c0 + 512 * j + 4)); } } \
        else { const bf16_t* xb_ = a.XBin + (size_t)r__ * DM; _Pragma("unroll") for (int j = 0; j < 2; ++j) xbn[s_][j] = __builtin_nontemporal_load((const u32x4*)(xb_ + c0 + 512 * j)); } \
        if (hasY) { const bf16_t* yr_ = a.Y + (size_t)r__ * DM; _Pragma("unroll") for (int j = 0; j < 2; ++j) yn[s_][j] = __builtin_nontemporal_load((const u32x4*)(yr_ + c0 + 512 * j)); } } while (0)
#define E_UNPK(w_, lo_, hi_) do { lo_ = (f32x4){bflo((w_).x), bfhi((w_).x), bflo((w_).y), bfhi((w_).y)}; hi_ = (f32x4){bflo((w_).z), bfhi((w_).z), bflo((w_).w), bfhi((w_).w)}; } while (0)
#pragma unroll
    for (int s = 0; s < RP; ++s) {
#pragma unroll
        for (int j = 0; j < 4; ++j) xn[s][j] = (f32x4){0.f, 0.f, 0.f, 0.f};
#pragma unroll
        for (int j = 0; j < 2; ++j) { yn[s][j] = (u32x4){0u, 0u, 0u, 0u}; xbn[s][j] = (u32x4){0u, 0u, 0u, 0u}; } }
#pragma unroll
    for (int s = 0; s < RP; ++s) { const int r = gw + s * NGW; if (r < a.M) E_LOAD(s, r); }
    f32x4 gyv[4], ghv[4], GG[4], VV[4], SS[4]; int curc = -1;
#pragma unroll
    for (int g = 0; g < 4; ++g) { const int co = c0 + 512 * (g >> 1) + 4 * (g & 1);
        gyv[g] = hasY ? *(const f32x4*)(a.gy + co) : (f32x4){0.f, 0.f, 0.f, 0.f}; ghv[g] = hasH ? *(const f32x4*)(a.gh + co) : (f32x4){0.f, 0.f, 0.f, 0.f};
        GG[g] = (f32x4){0.f, 0.f, 0.f, 0.f}; VV[g] = GG[g]; SS[g] = GG[g]; }
#define E_VEC(c_) do { if ((c_) != curc) { curc = (c_); \
        if (hasY) { const float* gt_ = a.modg + (size_t)curc * 6144 + a.goff; _Pragma("unroll") for (int g = 0; g < 4; ++g) GG[g] = *(const f32x4*)(gt_ + c0 + 512 * (g >> 1) + 4 * (g & 1)) * gyv[g]; } \
        if (hasH) { const float* sh_ = a.modh + (size_t)curc * 6144 + a.shoff; const float* sc_ = a.modh + (size_t)curc * 6144 + a.scoff; \
            _Pragma("unroll") for (int g = 0; g < 4; ++g) { const int co_ = c0 + 512 * (g >> 1) + 4 * (g & 1); VV[g] = ghv[g] * (*(const f32x4*)(sc_ + co_) + 1.0f); SS[g] = *(const f32x4*)(sh_ + co_); } } } } while (0)
    for (int row0 = gw; row0 < a.M; row0 += RP * NGW) {
        f32x4 xc[RP][4]; u32x4 yc[RP][2];
#pragma unroll
        for (int s = 0; s < RP; ++s) {
#pragma unroll
            for (int j = 0; j < 2; ++j) { f32x4 lo, hi; E_UNPK(xbn[s][j], lo, hi); xc[s][2 * j] = srcf ? xn[s][2 * j] : lo; xc[s][2 * j + 1] = srcf ? xn[s][2 * j + 1] : hi; yc[s][j] = yn[s][j]; } }
#pragma unroll
        for (int s = 0; s < RP; ++s) { const int r = row0 + (RP + s) * NGW; if (r < a.M) E_LOAD(s, r); }
#pragma unroll
        for (int s = 0; s < RP; ++s) {
            const int row = row0 + s * NGW;
            if (row < a.M) {
                const bool isl = row < M_LAT; const int cnd = isl ? (row >> 12) : 8;
                E_VEC(cnd);
                f32x4 x[4];
#pragma unroll
                for (int g = 0; g < 4; ++g) x[g] = xc[s][g];
                if (hasY) {
                    f32x4 y[4]; float ss = 0.f;
#pragma unroll
                    for (int j = 0; j < 2; ++j) E_UNPK(yc[s][j], y[2 * j], y[2 * j + 1]);
                    if (a.YP && !isl) {
#pragma unroll
                        for (int g = 0; g < 4; ++g) y[g] = (f32x4){0.f, 0.f, 0.f, 0.f};
                        for (int sl = 0; sl < 8; ++sl) { const bf16_t* yp = a.YP + ((size_t)sl * M_CTX + (row - M_LAT)) * DM;
#pragma unroll
                            for (int j = 0; j < 2; ++j) { const u32x4 w = *(const u32x4*)(yp + c0 + 512 * j); f32x4 lo, hi; E_UNPK(w, lo, hi); y[2 * j] += lo; y[2 * j + 1] += hi; } }
                    }
#pragma unroll
                    for (int g = 0; g < 4; ++g) ss += (y[g][0] * y[g][0] + y[g][1] * y[g][1]) + (y[g][2] * y[g][2] + y[g][3] * y[g][3]);
                    const float rstd = rsqrtf(wave_sum(ss) * (1.f / DM) + RMS_EPS);
#pragma unroll
                    for (int g = 0; g < 4; ++g) x[g] = x[g] + GG[g] * (y[g] * rstd);
                    if (a.outf) { float* xo = a.outf + (size_t)row * DM;
#pragma unroll
                        for (int g = 0; g < 4; ++g) __builtin_nontemporal_store(x[g], (f32x4*)(xo + c0 + 512 * (g >> 1) + 4 * (g & 1))); }
                    else { bf16_t* xo = a.XBout + (size_t)row * DM;
#pragma unroll
                        for (int j = 0; j < 2; ++j) { u32x4 w; w.x = cvt_pk_bf16(x[2 * j][0], x[2 * j][1]); w.y = cvt_pk_bf16(x[2 * j][2], x[2 * j][3]); w.z = cvt_pk_bf16(x[2 * j + 1][0], x[2 * j + 1][1]); w.w = cvt_pk_bf16(x[2 * j + 1][2], x[2 * j + 1][3]);
                            __builtin_nontemporal_store(w, (u32x4*)(xo + c0 + 512 * j));
                            E_UNPK(w, x[2 * j], x[2 * j + 1]); } }
                }
                if (hasH) {
                    float ss = 0.f;
#pragma unroll
                    for (int g = 0; g < 4; ++g) ss += (x[g][0] * x[g][0] + x[g][1] * x[g][1]) + (x[g][2] * x[g][2] + x[g][3] * x[g][3]);
                    const float rstd = rsqrtf(wave_sum(ss) * (1.f / DM) + RMS_EPS);
                    bf16_t* hr = a.H + (size_t)row * DM;
#pragma unroll
                    for (int j = 0; j < 2; ++j) { const f32x4 h0 = (x[2 * j] * rstd) * VV[2 * j] + SS[2 * j], h1 = (x[2 * j + 1] * rstd) * VV[2 * j + 1] + SS[2 * j + 1];
                        u32x4 w; w.x = cvt_pk_bf16(h0[0], h0[1]); w.y = cvt_pk_bf16(h0[2], h0[3]); w.z = cvt_pk_bf16(h1[0], h1[1]); w.w = cvt_pk_bf16(h1[2], h1[3]); *(u32x4*)(hr + c0 + 512 * j) = w; }
                }
            }
        }
    }
#undef E_LOAD
#undef E_UNPK
#undef E_VEC
}

__device__ __forceinline__ void phase_pool(const bf16_t* H, bf16_t* P, int M) {
    int tid_ = threadIdx.x; asm volatile("" : "+v"(tid_));
    const int lane = tid_ & 63, wave = __builtin_amdgcn_readfirstlane(tid_ >> 6);
    const int gw = blockIdx.x * NWAVES + wave, NGW = gridDim.x * NWAVES;
    const int per = (M + NGW - 1) / NGW;
    const int rbeg = gw * per, rend = min(rbeg + per, M);
    f32x4 S[4];
#pragma unroll
    for (int j = 0; j < 4; ++j) S[j] = (f32x4){0.f, 0.f, 0.f, 0.f};
#define LD4(r_, j_) ({ const u32x2 w_ = *(const u32x2*)(H + (size_t)(r_) * DM + 256 * (j_) + 4 * lane); (f32x4){bflo(w_.x), bfhi(w_.x), bflo(w_.y), bfhi(w_.y)}; })
    for (int row = rbeg; row < rend; ++row) {
        int seg0, L; if (row < M_LAT) { seg0 = row & ~(SEQ - 1); L = SEQ; } else { seg0 = M_LAT + ((row - M_LAT) & ~(CTXL - 1)); L = CTXL; }
        const int pos = row - seg0;
        if (row == rbeg || pos == 0) {
#pragma unroll
            for (int j = 0; j < 4; ++j) { const int half = 1 << j; f32x4 acc = (f32x4){0.f, 0.f, 0.f, 0.f};
#pragma unroll
                for (int i = 0; i < 2 * half; ++i) { const int q = pos - half + i; if (q >= 0 && q < L) acc += LD4(seg0 + q, j); }
                S[j] = acc; }
        } else {
#pragma unroll
            for (int j = 0; j < 4; ++j) { const int half = 1 << j; const int qa = pos + half - 1, qd = pos - half - 1;
                if (qa < L) S[j] += LD4(seg0 + qa, j);
                if (qd >= 0) S[j] -= LD4(seg0 + qd, j); }
        }
#pragma unroll
        for (int j = 0; j < 4; ++j) { const int half = 1 << j; const int lo = max(pos - half, 0), hi = min(pos + half, L);
            const f32x4 c = LD4(row, j); const float inv = 1.0f / (float)(hi - lo);
            const f32x4 o4 = S[j] * inv - c;
            u32x2 o; o.x = cvt_pk_bf16(o4[0], o4[1]); o.y = cvt_pk_bf16(o4[2], o4[3]);
            *(u32x2*)(P + (size_t)row * DM + 256 * j + 4 * lane) = o; }
    }
#undef LD4
}

__device__ __forceinline__ void phase_enorm_pool(const EArgs& a) {
    int tid_ = threadIdx.x; asm volatile("" : "+v"(tid_));
    const int lane = tid_ & 63, wave = __builtin_amdgcn_readfirstlane(tid_ >> 6);
    const int gw = blockIdx.x * NWAVES + wave, NGW = gridDim.x * NWAVES;
    const int M = a.M; const bf16_t* Z = a.Y;
    const int per = (M + NGW - 1) / NGW;
    const int rbeg = gw * per, rend = min(rbeg + per, M);
    constexpr int NS = 2;
    const int half_len = (per + 1) / 2;
    const bool srcf = a.xf_lat != nullptr;
    f32x4 S[NS][4];
#pragma unroll
    for (int s = 0; s < NS; ++s)
#pragma unroll
        for (int j = 0; j < 4; ++j) S[s][j] = (f32x4){0.f, 0.f, 0.f, 0.f};
    f32x4 gyv[4], ghv[4], GG[4], VV[4], SS[4]; int curc = -1;
#pragma unroll
    for (int j = 0; j < 4; ++j) { gyv[j] = *(const f32x4*)(a.gy + 4 * lane + 256 * j); ghv[j] = *(const f32x4*)(a.gh + 4 * lane + 256 * j); GG[j] = (f32x4){0.f, 0.f, 0.f, 0.f}; VV[j] = GG[j]; SS[j] = GG[j]; }
#define LD4(r_, j_) ({ const u32x2 w_ = *(const u32x2*)(Z + (size_t)(r_) * DM + 256 * (j_) + 4 * lane); (f32x4){bflo(w_.x), bfhi(w_.x), bflo(w_.y), bfhi(w_.y)}; })
    for (int i = 0; i < half_len; ++i) {
#pragma unroll
        for (int s = 0; s < NS; ++s) {
            const int row = rbeg + s * half_len + i;
            if (row < rend && (s == 1 || row < rbeg + half_len)) {
                const bool isl = row < M_LAT; const int cnd = isl ? (row >> 12) : 8;
                int seg0, L; if (isl) { seg0 = row & ~(SEQ - 1); L = SEQ; } else { seg0 = M_LAT + ((row - M_LAT) & ~(CTXL - 1)); L = CTXL; }
                const int pos = row - seg0;
                f32x4 x[4];
                if (srcf) { const float* xin = isl ? a.xf_lat + (size_t)row * DM : a.xf_ctx + (size_t)(row - M_LAT) * DM;
#pragma unroll
                    for (int j = 0; j < 4; ++j) x[j] = *(const f32x4*)(xin + 4 * lane + 256 * j); }
                else { const bf16_t* xb = a.XBin + (size_t)row * DM;
#pragma unroll
                    for (int j = 0; j < 4; ++j) { const u32x2 w = *(const u32x2*)(xb + 4 * lane + 256 * j); x[j] = (f32x4){bflo(w.x), bfhi(w.x), bflo(w.y), bfhi(w.y)}; } }
                if (i == 0 || pos == 0) {
#pragma unroll
                    for (int j = 0; j < 4; ++j) { const int half = 1 << j; f32x4 acc = (f32x4){0.f, 0.f, 0.f, 0.f};
#pragma unroll
                        for (int k = 0; k < 2 * half; ++k) { const int q = pos - half + k; if (q >= 0 && q < L) acc += LD4(seg0 + q, j); }
                        S[s][j] = acc; }
                } else {
#pragma unroll
                    for (int j = 0; j < 4; ++j) { const int half = 1 << j; const int qa = pos + half - 1, qd = pos - half - 1;
                        if (qa < L) S[s][j] += LD4(seg0 + qa, j);
                        if (qd >= 0) S[s][j] -= LD4(seg0 + qd, j); }
                }
                f32x4 y[4]; float ss = 0.f;
#pragma unroll
                for (int j = 0; j < 4; ++j) { const int half = 1 << j; const int lo = max(pos - half, 0), hi = min(pos + half, L);
                    const f32x4 c = LD4(row, j); const float inv = 1.0f / (float)(hi - lo);
                    y[j] = S[s][j] * inv - c;
                    ss += (y[j][0] * y[j][0] + y[j][1] * y[j][1]) + (y[j][2] * y[j][2] + y[j][3] * y[j][3]); }
                const float rstd = rsqrtf(wave_sum(ss) * (1.f / DM) + RMS_EPS);
                if (cnd != curc) { curc = cnd; const float* gt_ = a.modg + (size_t)cnd * 6144 + a.goff; const float* sh_ = a.modh + (size_t)cnd * 6144 + a.shoff; const float* sc_ = a.modh + (size_t)cnd * 6144 + a.scoff;
#pragma unroll
                    for (int j = 0; j < 4; ++j) { GG[j] = *(const f32x4*)(gt_ + 4 * lane + 256 * j) * gyv[j]; VV[j] = ghv[j] * (*(const f32x4*)(sc_ + 4 * lane + 256 * j) + 1.0f); SS[j] = *(const f32x4*)(sh_ + 4 * lane + 256 * j); } }
                bf16_t* xo = a.XBout + (size_t)row * DM;
                float sx = 0.f;
#pragma unroll
                for (int j = 0; j < 4; ++j) { const f32x4 xn = x[j] + GG[j] * (y[j] * rstd);
                    u32x2 w; w.x = cvt_pk_bf16(xn[0], xn[1]); w.y = cvt_pk_bf16(xn[2], xn[3]); __builtin_nontemporal_store(w, (u32x2*)(xo + 4 * lane + 256 * j));
                    x[j] = (f32x4){bflo(w.x), bfhi(w.x), bflo(w.y), bfhi(w.y)};
                    sx += (x[j][0] * x[j][0] + x[j][1] * x[j][1]) + (x[j][2] * x[j][2] + x[j][3] * x[j][3]); }
                const float rstd2 = rsqrtf(wave_sum(sx) * (1.f / DM) + RMS_EPS);
                bf16_t* hr = a.H + (size_t)row * DM;
#pragma unroll
                for (int j = 0; j < 4; ++j) { const f32x4 h = (x[j] * rstd2) * VV[j] + SS[j];
                    u32x2 w; w.x = cvt_pk_bf16(h[0], h[1]); w.y = cvt_pk_bf16(h[2], h[3]); *(u32x2*)(hr + 4 * lane + 256 * j) = w; }
            }
        }
    }
#undef LD4
}

__device__ __forceinline__ void phase_emla(const bf16_t* A, bf16_t* QA, bf16_t* KVA, bf16_t* KR, const float* gq, const float* gkv) {
    int tid_ = threadIdx.x; asm volatile("" : "+v"(tid_));
    const int lane = tid_ & 63, wave = __builtin_amdgcn_readfirstlane(tid_ >> 6);
    const int gw = blockIdx.x * NWAVES + wave, NGW = gridDim.x * NWAVES;
    float g0[8], g1[8];
#pragma unroll
    for (int i = 0; i < 8; ++i) { g0[i] = lane < 48 ? gq[lane * 8 + i] : gkv[(lane - 48) * 8 + i]; g1[i] = lane < 16 ? gkv[128 + lane * 8 + i] : 1.f; }
    for (int row = gw; row < M_ALL; row += NGW) {
        const bf16_t* ar = A + (size_t)row * 768;
        const bf16x8 v0 = *(const bf16x8*)(ar + lane * 8);
        bf16x8 v1 = (bf16x8){0, 0, 0, 0, 0, 0, 0, 0};
        if (lane < 24) v1 = *(const bf16x8*)(ar + 512 + lane * 8);
        float f0[8], f1[8]; float ss0 = 0.f, ss1 = 0.f;
#pragma unroll
        for (int i = 0; i < 8; ++i) { f0[i] = bf2f((unsigned short)v0[i]); f1[i] = bf2f((unsigned short)v1[i]); ss0 += f0[i] * f0[i]; ss1 += f1[i] * f1[i]; }
        const float sq = wave_sum(lane < 48 ? ss0 : 0.f);
        const float skv = wave_sum((lane >= 48 ? ss0 : 0.f) + (lane < 16 ? ss1 : 0.f));
        const float rq = rsqrtf(sq * (1.f / 384.f) + RMS_EPS), rkv = rsqrtf(skv * (1.f / 256.f) + RMS_EPS);
        float oth[8];
#pragma unroll
        for (int i = 0; i < 8; ++i) oth[i] = __shfl_xor(f1[i], 4);
        float ov[8];
        if (lane < 48) {
#pragma unroll
            for (int i = 0; i < 8; ++i) ov[i] = f0[i] * rq * g0[i];
            u32x4 w; w.x = cvt_pk_bf16(ov[0], ov[1]); w.y = cvt_pk_bf16(ov[2], ov[3]); w.z = cvt_pk_bf16(ov[4], ov[5]); w.w = cvt_pk_bf16(ov[6], ov[7]);
            *(u32x4*)(QA + (size_t)row * 384 + lane * 8) = w;
        } else {
#pragma unroll
            for (int i = 0; i < 8; ++i) ov[i] = f0[i] * rkv * g0[i];
            u32x4 w; w.x = cvt_pk_bf16(ov[0], ov[1]); w.y = cvt_pk_bf16(ov[2], ov[3]); w.z = cvt_pk_bf16(ov[4], ov[5]); w.w = cvt_pk_bf16(ov[6], ov[7]);
            *(u32x4*)(KVA + (size_t)row * 256 + (lane - 48) * 8) = w;
        }
        if (lane < 16) {
#pragma unroll
            for (int i = 0; i < 8; ++i) ov[i] = f1[i] * rkv * g1[i];
            u32x4 w; w.x = cvt_pk_bf16(ov[0], ov[1]); w.y = cvt_pk_bf16(ov[2], ov[3]); w.z = cvt_pk_bf16(ov[4], ov[5]); w.w = cvt_pk_bf16(ov[6], ov[7]);
            *(u32x4*)(KVA + (size_t)row * 256 + 128 + lane * 8) = w;
        } else if (lane < 24) {
            const int c = lane - 16;
            if (row < M_LAT) {
                const int t = row & (SEQ - 1); const float grow = (float)(t >> 6), gcol = (float)(t & 63);
#pragma unroll
                for (int i = 0; i < 8; ++i) { const int ii = (c & 3) * 8 + i; const float pos = ii < 16 ? grow : gcol;
                    const float inv = __builtin_amdgcn_exp2f(-(float)(ii & 15) * 0.8304820237218406f);
                    const float ang = pos * inv; const float cs = __cosf(ang), sn = __sinf(ang);
                    ov[i] = (c < 4) ? (f1[i] * cs - oth[i] * sn) : (oth[i] * sn + f1[i] * cs); }
            } else {
#pragma unroll
                for (int i = 0; i < 8; ++i) ov[i] = f1[i];
            }
            u32x4 w; w.x = cvt_pk_bf16(ov[0], ov[1]); w.y = cvt_pk_bf16(ov[2], ov[3]); w.z = cvt_pk_bf16(ov[4], ov[5]); w.w = cvt_pk_bf16(ov[6], ov[7]);
            *(u32x4*)(KR + (size_t)row * 64 + c * 8) = w;
        }
    }
}

__device__ __forceinline__ int vcu_of(int bx, int G) { return (G % 8 == 0) ? (bx % 8) * (G / 8) + bx / 8 : bx; }

__device__ __forceinline__ void phase_attn_mla(unsigned char* ws, unsigned char* hb, LAS unsigned char* lds) {
    const int G = gridDim.x, vcu = vcu_of(blockIdx.x, G);
    const bf16_t* Q = (const bf16_t*)(ws + S_Q); const bf16_t* KV = (const bf16_t*)(ws + S_KV); const bf16_t* KR = (const bf16_t*)(ws + Y_KR); bf16_t* O = (bf16_t*)(hb + H_O);
    const float C = 0.07216878364870322f * LOG2E;
    for (int un = vcu; un < 1024 + 64; un += G) {
        att::AttnU u;
        int b, h, qrow0;
        if (un < 1024) { b = un >> 7; h = (un >> 4) & 7; const int qb = un & 15; qrow0 = b * SEQ + qb * 256; u.rope_pos0 = qb * 256; u.NT = 4 + 64; }
        else { const int c = un - 1024; b = c >> 3; h = c & 7; qrow0 = M_LAT + b * CTXL; u.rope_pos0 = -1; u.NT = 4; }
        u.Qw = Q + (size_t)qrow0 * 1536 + h * 192; u.ldq = 1536;
        u.K0 = KV + h * 256; u.ldk0 = 2048; u.K2 = KR; u.ldk2 = 64; u.V = KV + h * 256 + 128; u.ldv = 2048;
        u.O = O + (size_t)qrow0 * 1024 + h * 128; u.ldo = 1024;
        u.baseA = M_LAT + b * CTXL; u.nA = 4; u.baseB = b * SEQ;
        u.lo = 0; u.r0 = 0; u.rpb_h = nullptr;
        att::attn_unit<12, 4, 0>(lds, u, C);
    }
}
__device__ __forceinline__ void phase_attn_na(unsigned char* ws, unsigned char* hb, const float* rpb, LAS unsigned char* lds) {
    const int G = gridDim.x, vcu = vcu_of(blockIdx.x, G);
    const bf16_t* Qb = (const bf16_t*)(ws + S_QKV); const bf16_t* Kp = Qb + (size_t)M_ALL * 1024; const bf16_t* Vp = Kp + (size_t)128 * 4352 * 64; bf16_t* O = (bf16_t*)(hb + H_O);
    const float C = 0.125f * LOG2E;
    for (int un = vcu; un < 2048; un += G) {
        att::AttnU u;
        const int b = un >> 8, h = (un >> 4) & 15, rg = un & 15; const int r0 = rg * 4;
        const int lo = min(max(r0 - 4, 0), 56), hiE = min(max(r0 + 3 - 4, 0), 56) + 8;
        const int qrow0 = b * SEQ + r0 * 64;
        u.Qw = Qb + (size_t)qrow0 * 1024 + h * 64; u.ldq = 1024;
        u.K0 = Kp + (size_t)(b * 16 + h) * 4352 * 64; u.ldk0 = 64; u.K2 = nullptr; u.ldk2 = 0; u.V = Vp + (size_t)(b * 16 + h) * 4352 * 64; u.ldv = 64;
        u.O = O + (size_t)qrow0 * 1024 + h * 64; u.ldo = 1024;
        u.baseA = lo * 64; u.nA = hiE - lo; u.baseB = 4096; u.NT = u.nA + 4;
        u.rope_pos0 = -1; u.lo = lo; u.r0 = r0; u.rpb_h = rpb + h * 465;
        att::attn_unit_na2(lds, u, C);
    }
}

#ifdef SITE_MASK
#define GEMM_SITE(i, call) do { if ((SITE_MASK >> (i)) & 1) { call; } } while (0)
#else
#define GEMM_SITE(i, call) call
#endif
constexpr int LDS_BYTES = 147456;
constexpr int MISC_OFF = 131072 + 320;

__device__ __forceinline__ void run_enorm(int layer, int which  , int Mrows) {
    const ParamsView p = kargs(); unsigned char* ws = p.ws;
    const float* MOD = (const float*)(ws + WS_MOD); const float* norm_g = p.in[6];
    bf16_t* Hb = (bf16_t*)p.out; bf16_t* Yb = (bf16_t*)(ws + WS_Y); bf16_t* XB = (bf16_t*)(ws + WS_X);
    const float* ng = norm_g + layer * 4 * DM; const float* modl = MOD + (size_t)layer * 9 * 6144;
    EArgs a; a.xf_lat = nullptr; a.xf_ctx = nullptr; a.XBin = XB; a.XBout = XB; a.outf = nullptr; a.Y = Yb; a.modg = modl; a.H = Hb; a.modh = modl; a.M = Mrows; a.YP = nullptr;
    if (which == 0) { a.xf_lat = p.in[0]; a.xf_ctx = p.in[2]; a.Y = nullptr; a.gy = ng; a.goff = 0; a.gh = ng; a.shoff = 0; a.scoff = DM; }
    else if (which == 1) { if (layer == 0) { a.xf_lat = p.in[0]; a.xf_ctx = p.in[2]; } if (layer % 3 == 1) a.YP = (const bf16_t*)((unsigned char*)p.out + HB_YP); a.gy = ng + DM; a.goff = 2 * DM; a.gh = ng + 2 * DM; a.shoff = 3 * DM; a.scoff = 4 * DM; }
    else { if (Mrows == M_ALL) a.YP = (const bf16_t*)((unsigned char*)p.out + HB_YP);
           a.gy = ng + 3 * DM; a.goff = 5 * DM; if (layer == 3) { a.H = nullptr; a.outf = p.out; } a.gh = ng + 4 * DM; a.modh = modl + 9 * 6144; a.shoff = 0; a.scoff = DM; }
    if (which == 1 && (layer % 3) == 0) phase_enorm_pool(a); else phase_enorm(a);
}
__device__ __forceinline__ void run_gemm(int layer, int gid, int Mrows, LAS unsigned char* lds) {
    const ParamsView p = kargs(); unsigned char* ws = p.ws;
    unsigned char* hb = (unsigned char*)p.out; bf16_t* Hb = (bf16_t*)hb; bf16_t* Yb = (bf16_t*)(ws + WS_Y);
    pg8::Gemm g; bf16_t* GO; int gldc; int swi = 0;
    switch (gid) {
    case 0: g = pg8::Gemm{Hb, (const bf16_t*)(ws + W_GU + layer * SZ_GU), Mrows, 2 * FFH, 1024, 1024, 1024, 0}; GO = (bf16_t*)(ws + S_ACT); gldc = FFH; swi = 1; break;
    case 1: g = pg8::Gemm{(const bf16_t*)(ws + S_ACT), (const bf16_t*)(ws + W_DN + layer * SZ_DN), Mrows, 1024, FFH, FFH, FFH, 0}; GO = Yb; gldc = 1024; break;
    case 2: g = pg8::Gemm{Hb, (const bf16_t*)(ws + W_POOL + (layer / 3) * SZ_POOL), Mrows, 1024, 256, 1024, 256, 256}; GO = Yb; gldc = 1024; break;
    case 3: g = pg8::Gemm{Hb, (const bf16_t*)(ws + W_MIN), M_ALL, 768, 1024, 1024, 1024, 0}; GO = (bf16_t*)(ws + Y_A); gldc = 768; break;
    case 4: g = pg8::Gemm{(const bf16_t*)(hb + H_QA), (const bf16_t*)(ws + W_QB), M_ALL, 1536, 384, 384, 384, 0}; GO = (bf16_t*)(ws + S_Q); gldc = 1536; break;
    case 5: g = pg8::Gemm{(const bf16_t*)(hb + H_KVA), (const bf16_t*)(ws + W_KVB), M_ALL, 2048, 256, 256, 256, 0}; GO = (bf16_t*)(ws + S_KV); gldc = 2048; break;
    case 6: g = pg8::Gemm{(const bf16_t*)(hb + H_O), (const bf16_t*)(ws + W_MO), M_ALL, 1024, 1024, 1024, 1024, 0}; GO = Yb; gldc = 1024; break;
    case 7: g = pg8::Gemm{Hb, (const bf16_t*)(ws + W_NIN), M_ALL, 3072, 1024, 1024, 1024, 0}; GO = (bf16_t*)(ws + S_QKV); gldc = 1024; swi = 2; break;
    default: g = pg8::Gemm{(const bf16_t*)(hb + H_O), (const bf16_t*)(ws + W_NO), M_LAT, 1024, 1024, 1024, 1024, 0}; GO = Yb; gldc = 1024; break;
    }
    const bool split = ((gid == 1) && (Mrows == M_ALL)) || (gid == 6);
    const int nrep = split ? 9 : 1; const int G = (int)gridDim.x; int cidx = (int)blockIdx.x;
    if (split) g.M = M_LAT;
    for (int rep = 0; rep < nrep; ++rep) {
        if (rep > 0) { const int sl = rep - 1;
            if (gid == 1) { const int k0 = sl < 6 ? 384 * sl : 2304 + 256 * (sl - 6); const int Ks = sl < 6 ? 384 : 256;
                g = pg8::Gemm{(const bf16_t*)(ws + S_ACT) + (size_t)M_LAT * FFH + k0, (const bf16_t*)(ws + W_DN + layer * SZ_DN) + k0, M_CTX, 1024, Ks, FFH, FFH, 0}; }
            else { const int k0 = 128 * sl;
                g = pg8::Gemm{(const bf16_t*)(hb + H_O) + (size_t)M_LAT * DM + k0, (const bf16_t*)(ws + W_MO) + k0, M_CTX, 1024, 128, 1024, 1024, 0}; }
            GO = (bf16_t*)(hb + HB_YP) + (size_t)sl * M_CTX * DM; gldc = 1024; cidx = ((int)blockIdx.x + G - (G / 8) * sl) % G; }
        pg8::gemm_phase(lds, g, G, cidx, GO, gldc, swi);
    }
}

__global__ void __launch_bounds__(NTHREADS, 2) mega_fwd(Params p_unused) {
    extern __shared__ __attribute__((aligned(16))) unsigned char lds_raw[];
    LAS unsigned char* lds = (LAS unsigned char*)lds_raw;
    cg::grid_group grid = cg::this_grid();
    const int tid = threadIdx.x;
    for (int u = tid; u < (LDS_BYTES - 131072) / 4; u += NTHREADS) ((LAS unsigned*)(lds + 131072))[u] = 0u;
    __syncthreads();
#if USE_CG_SYNC
#define GRID_BAR() grid.sync()
#else
    { XcdBarrier b0 = xcd_barrier_post((unsigned*)(kargs().ws + WS_CTL) + 64, (volatile LAS unsigned*)(lds + MISC_OFF) + 8); (void)b0; }
#define GRID_BAR() do { XcdBarrier b_; b_.bar = (unsigned*)(kargs().ws + WS_CTL) + 64; b_.x = xb_xcc_id(); b_.st = (volatile LAS unsigned*)(lds + MISC_OFF) + 8; xcd_barrier(b_); } while (0)
#endif
#ifndef NO_P0
    phase_p0(lds);
#endif
    grid.sync();
    run_enorm(0, 0, M_ALL);
    GRID_BAR();

    for (int layer = 0; layer < 4; ++layer) {
        const int kind = layer % 3;
        const int Mrows = layer >= 2 ? M_LAT : M_ALL;
        const int nsteps = kind == 0 ? 5 : (kind == 1 ? 10 : 7);
        for (int s = 0; s < nsteps; ++s) {
            const int t = s - (nsteps - 4);
            int op; bool sync_after = true;
            if (t >= 0) { op = t == 0 ? 10 : (t == 1 ? 0 : (t == 2 ? 1 : 11)); if (t == 3 && layer == 3) sync_after = false; }
            else if (kind == 0) op = 2;
            else if (kind == 1) { op = s == 0 ? 3 : (s == 1 ? 13 : (s == 2 ? 4 : (s == 3 ? 5 : (s == 4 ? 14 : 6)))); if (s == 2) sync_after = false; }
            else op = s == 0 ? 7 : (s == 1 ? 15 : 8);
            if (op < 9) run_gemm(layer, op, Mrows, lds);
            else if (op == 10) run_enorm(layer, 1, Mrows);
            else if (op == 11) run_enorm(layer, 2, Mrows);
            else if (op == 12) { const ParamsView p = kargs(); phase_pool((const bf16_t*)p.out, (bf16_t*)(p.ws + S_P), Mrows); }
            else if (op == 13) { const ParamsView p = kargs(); unsigned char* ws = p.ws; phase_emla((const bf16_t*)(ws + Y_A), (bf16_t*)((unsigned char*)p.out + H_QA), (bf16_t*)((unsigned char*)p.out + H_KVA), (bf16_t*)(ws + Y_KR), p.in[12], p.in[13]); }
#ifndef NO_ATT_MLA
            else if (op == 14) { const ParamsView p = kargs(); phase_attn_mla(p.ws, (unsigned char*)p.out, lds); }
#endif
#ifndef NO_ATT_NA
            else if (op == 15) { const ParamsView p = kargs(); phase_attn_na(p.ws, (unsigned char*)p.out, p.in[18], lds); }
#endif
            if (sync_after) GRID_BAR();
        }
    }
}

extern "C" void kernel_launch(void* const* d_in, const int* in_sizes, int n_in, void* d_out, int out_size, void* d_ws, size_t ws_size, hipStream_t stream) {
    static int grid = 0;
    if (grid == 0) {
        if (n_in != 20 || out_size != M_LAT * DM || ws_size < WS_END) { fprintf(stderr, "kernel_launch: unexpected shapes: n_in %d out %d ws %zu (need %zu)\n", n_in, out_size, ws_size, (size_t)WS_END); grid = -1; return; }
        int dev = 0, cus = 0, per_cu = 0;
        if (hipGetDevice(&dev) != hipSuccess || hipDeviceGetAttribute(&cus, hipDeviceAttributeMultiprocessorCount, dev) != hipSuccess) { grid = -1; return; }
        if (hipFuncSetAttribute((const void*)mega_fwd, hipFuncAttributeMaxDynamicSharedMemorySize, LDS_BYTES) != hipSuccess) { fprintf(stderr, "kernel_launch: hipFuncSetAttribute failed\n"); grid = -1; return; }
        if (hipOccupancyMaxActiveBlocksPerMultiprocessor(&per_cu, (const void*)mega_fwd, NTHREADS, LDS_BYTES) != hipSuccess || per_cu < 1) { fprintf(stderr, "kernel_launch: occupancy query says %d\n", per_cu); per_cu = 1; }
        (void)hipGetLastError();
        grid = cus;
    }
    if (grid < 0) return;
    (void)hipMemsetAsync((char*)d_ws + WS_CTL, 0, CTL_BYTES, stream);
    Params p{};
    for (int i = 0; i < 20; ++i) p.in[i] = (const float*)d_in[i];
    p.out = (float*)d_out; p.ws = (unsigned char*)d_ws;
    void* args[] = {&p};
    hipError_t e = hipLaunchCooperativeKernel((const void*)mega_fwd, dim3(grid), dim3(NTHREADS), args, LDS_BYTES, stream);
    if (e != hipSuccess) fprintf(stderr, "kernel_launch: cooperative launch failed: %s (grid %d)\n", hipGetErrorString(e), grid);
}
```
